# Optimizing an MI355X kernel written in HIP

```python
import functools
import jax, jax.numpy as jnp
from jax import lax
import numpy as np

D_MODEL = 2048
BATCH = 4
SEQ = 2048
DEPTH = 1
DEC_BATCH = 32
DEC_SEQ = 4
PAST_LEN = 16384
PAGE_SIZE = 128

N_META = 16
D_CONV = D_MODEL // 2
CONV_WIDTH = 3
HEAD_DIM = 64
N_HEADS = (D_MODEL // 2) // HEAD_DIM
N_KV_HEADS = N_HEADS // 4
GROUP = N_HEADS // N_KV_HEADS
Q_DIM = N_HEADS * HEAD_DIM
KV_DIM = N_KV_HEADS * HEAD_DIM
WINDOW = 128
BLOCK = 128
D_FF = ((8 * D_MODEL // 3 + 127) // 128) * 128
N_BRANCH = 2
IN_SPLITS = (D_CONV, 2 * D_CONV, 3 * D_CONV, 3 * D_CONV + Q_DIM,
             3 * D_CONV + Q_DIM + KV_DIM, 3 * D_CONV + Q_DIM + 2 * KV_DIM,
             3 * D_CONV + Q_DIM + 2 * KV_DIM + D_MODEL)
D_IN = 3 * D_CONV + Q_DIM + 2 * KV_DIM + N_BRANCH * D_MODEL
EPS = 1e-6
NEG_INF = -1e30

kernel_name = "hybrid_conv_swa_macaron_step"


def rms_norm(x, g):
    xf = x.astype(jnp.float32)
    y = xf * lax.rsqrt(jnp.mean(xf * xf, axis=-1, keepdims=True) + EPS)
    return (y * g.astype(jnp.float32)).astype(x.dtype)


def half_ffn(x, g, w_up, w_down):
    h = rms_norm(x, g)
    gate, up = jnp.split(h @ w_up, 2, axis=-1)
    return x + 0.5 * ((jax.nn.silu(gate) * up) @ w_down)


def alibi_slopes():
    h = jnp.arange(1, N_HEADS + 1, dtype=jnp.float32)
    return jnp.exp2(-8.0 * h / N_HEADS).reshape(N_KV_HEADS, GROUP)


def project(h, w_in, q_g, k_g):
    z = h @ w_in
    xc, bg, cg, q, k, v, gc, ga = jnp.split(z, IN_SPLITS, axis=-1)
    lead = h.shape[:-1]
    q = rms_norm(q.reshape(*lead, N_KV_HEADS, GROUP, HEAD_DIM), q_g) * (HEAD_DIM ** -0.5)
    k = rms_norm(k.reshape(*lead, N_KV_HEADS, HEAD_DIM), k_g)
    v = v.reshape(*lead, N_KV_HEADS, HEAD_DIM)
    return xc, bg, cg, q, k, v, jax.nn.sigmoid(gc), jax.nn.sigmoid(ga)


def short_conv(xc, bg, cg, prefix, conv_w, w_out):
    u = cg * xc
    L = u.shape[1]
    up = jnp.concatenate([prefix.astype(u.dtype), u], axis=1)
    y = conv_w[0] * up[:, 0:L]
    for j in range(1, CONV_WIDTH):
        y = y + conv_w[j] * up[:, j:j + L]
    return (bg * y) @ w_out, up[:, L:]


def window_attention(q, k, v, pos_q, pos_k, sinks):
    s = jnp.einsum('...qkgd,...skd->...kgqs', q, k, preferred_element_type=jnp.float32)
    dist = (pos_q[..., :, None] - pos_k[..., None, :])[..., None, None, :, :]
    mask = (dist >= 0) & (dist <= WINDOW) & (pos_k[..., None, None, None, :] >= 0)
    s = jnp.where(mask, s - alibi_slopes()[:, :, None, None] * dist.astype(jnp.float32), NEG_INF)
    sink = jnp.broadcast_to(sinks.astype(jnp.float32).reshape(N_KV_HEADS, GROUP, 1, 1),
                            s.shape[:-1] + (1,))
    p = jax.nn.softmax(jnp.concatenate([s, sink], axis=-1), axis=-1)[..., :-1]
    return jnp.einsum('...kgqs,...skd->...qkgd', p.astype(v.dtype), v)


def prompt_attention(q, k, v, sinks):
    B, L = q.shape[0], q.shape[1]
    pad = BLOCK - N_META
    Lp = L + pad
    nb = Lp // BLOCK
    padf = lambda a: jnp.pad(a, ((0, 0), (pad, 0)) + ((0, 0),) * (a.ndim - 2))
    qb = padf(q).reshape(B, nb, BLOCK, N_KV_HEADS, GROUP, HEAD_DIM)
    kb = padf(k).reshape(B, nb, BLOCK, N_KV_HEADS, HEAD_DIM)
    vb = padf(v).reshape(B, nb, BLOCK, N_KV_HEADS, HEAD_DIM)
    shift = lambda a: jnp.concatenate([jnp.zeros_like(a[:, :1]), a[:, :-1]], axis=1)
    kk = jnp.concatenate([shift(kb), kb], axis=2)
    vv = jnp.concatenate([shift(vb), vb], axis=2)
    pos_q = (jnp.arange(Lp, dtype=jnp.int32) - pad).reshape(nb, BLOCK)
    pos_k = jnp.concatenate([pos_q - BLOCK, pos_q], axis=1)
    o = window_attention(qb, kk, vv, pos_q, pos_k, sinks)
    n_win = min(WINDOW, L)
    return o.reshape(B, Lp, Q_DIM)[:, pad:], k[:, L - n_win:], v[:, L - n_win:]


def sample_attention(q, k, v, cache_k, cache_v, sinks):
    Bd, T = q.shape[0], q.shape[1]
    n_buf = cache_k.shape[1]
    kk = jnp.concatenate([cache_k.astype(k.dtype), k], axis=1)
    vv = jnp.concatenate([cache_v.astype(v.dtype), v], axis=1)
    pos_q = jnp.arange(T, dtype=jnp.int32) + PAST_LEN
    pos_k = jnp.arange(n_buf + T, dtype=jnp.int32) + (PAST_LEN - n_buf)
    o = window_attention(q, kk, vv, pos_q, pos_k, sinks)
    return o.reshape(Bd, T, Q_DIM), kk[:, T:], vv[:, T:]


def layer_forward(x, conv_prefix, attend, g_ffn1, w_up1, w_down1, g_mix, w_in, q_g, k_g,
                  conv_w, w_conv_out, w_attn_out, w_o, g_ffn2, w_up2, w_down2):
    x = half_ffn(x, g_ffn1, w_up1, w_down1)
    h = rms_norm(x, g_mix)
    xc, bg, cg, q, k, v, gate_c, gate_a = project(h, w_in, q_g, k_g)
    conv_out, new_conv = short_conv(xc, bg, cg, conv_prefix, conv_w, w_conv_out)
    attn, new_k, new_v = attend(q, k, v)
    attn_out = attn @ w_attn_out
    x = x + (gate_c * conv_out + gate_a * attn_out) @ w_o
    x = half_ffn(x, g_ffn2, w_up2, w_down2)
    return x, new_conv, new_k, new_v


def setup_inputs(seed: int = 0) -> dict:
    key = jax.random.key(seed)
    ks = jax.random.split(key, 24)
    n_win = min(WINDOW, PAST_LEN)
    nrm = lambda k, shape, scale: jax.random.normal(k, shape, jnp.float32) * scale
    gain = lambda k, shape: 1.0 + 0.02 * jax.random.normal(k, shape, jnp.float32)
    return {
        "x_prompt": nrm(ks[0], (BATCH, SEQ, D_MODEL), 1.0),
        "x_sample": nrm(ks[1], (DEC_BATCH, DEC_SEQ, D_MODEL), 1.0),
        "state_conv": nrm(ks[2], (DEPTH, DEC_BATCH, CONV_WIDTH - 1, D_CONV), 1.0),
        "cache_k_win": nrm(ks[3], (DEPTH, DEC_BATCH, n_win, N_KV_HEADS, HEAD_DIM), 1.0),
        "cache_v_win": nrm(ks[4], (DEPTH, DEC_BATCH, n_win, N_KV_HEADS, HEAD_DIM), 1.0),
        "meta_tokens": nrm(ks[5], (N_META, D_MODEL), 1.0),
        "ffn1_norm": gain(ks[6], (DEPTH, D_MODEL)),
        "ffn1_w_up": nrm(ks[7], (DEPTH, D_MODEL, 2 * D_FF), D_MODEL ** -0.5),
        "ffn1_w_down": nrm(ks[8], (DEPTH, D_FF, D_MODEL), D_FF ** -0.5),
        "mix_norm": gain(ks[9], (DEPTH, D_MODEL)),
        "w_in": nrm(ks[10], (DEPTH, D_MODEL, D_IN), D_MODEL ** -0.5),
        "q_norm": gain(ks[11], (DEPTH, HEAD_DIM)),
        "k_norm": gain(ks[12], (DEPTH, HEAD_DIM)),
        "conv_w": nrm(ks[13], (DEPTH, CONV_WIDTH, D_CONV), CONV_WIDTH ** -0.5),
        "w_conv_out": nrm(ks[14], (DEPTH, D_CONV, D_MODEL), D_CONV ** -0.5),
        "attn_sinks": nrm(ks[15], (DEPTH, N_HEADS), 0.5),
        "w_attn_out": nrm(ks[16], (DEPTH, Q_DIM, D_MODEL), Q_DIM ** -0.5),
        "w_o": nrm(ks[17], (DEPTH, D_MODEL, D_MODEL), D_MODEL ** -0.5),
        "ffn2_norm": gain(ks[18], (DEPTH, D_MODEL)),
        "ffn2_w_up": nrm(ks[19], (DEPTH, D_MODEL, 2 * D_FF), D_MODEL ** -0.5),
        "ffn2_w_down": nrm(ks[20], (DEPTH, D_FF, D_MODEL), D_FF ** -0.5),
    }


def reference(x_prompt, x_sample, state_conv, cache_k_win, cache_v_win, meta_tokens,
              ffn1_norm, ffn1_w_up, ffn1_w_down, mix_norm, w_in, q_norm, k_norm,
              conv_w, w_conv_out, attn_sinks, w_attn_out, w_o,
              ffn2_norm, ffn2_w_up, ffn2_w_down):
    B = x_prompt.shape[0]
    meta = jnp.broadcast_to(meta_tokens[None].astype(x_prompt.dtype), (B, N_META, D_MODEL))
    xp = jnp.concatenate([meta, x_prompt], axis=1)
    xs = x_sample
    conv_p, k_p, v_p, conv_s, k_s, v_s = [], [], [], [], [], []
    for l in range(DEPTH):
        w = (ffn1_norm[l], ffn1_w_up[l], ffn1_w_down[l], mix_norm[l], w_in[l], q_norm[l], k_norm[l],
             conv_w[l], w_conv_out[l], w_attn_out[l], w_o[l], ffn2_norm[l], ffn2_w_up[l], ffn2_w_down[l])
        zero_prefix = jnp.zeros((B, CONV_WIDTH - 1, D_CONV), xp.dtype)
        xp, cp, kp, vp = layer_forward(
            xp, zero_prefix, functools.partial(prompt_attention, sinks=attn_sinks[l]), *w)
        xs, cs, ksn, vsn = layer_forward(
            xs, state_conv[l],
            functools.partial(sample_attention, cache_k=cache_k_win[l], cache_v=cache_v_win[l],
                              sinks=attn_sinks[l]), *w)
        conv_p.append(cp); k_p.append(kp); v_p.append(vp)
        conv_s.append(cs); k_s.append(ksn); v_s.append(vsn)
    y_prompt = xp[:, N_META:]
    y_sample = xs
    return (y_prompt, y_sample, jnp.stack(conv_p), jnp.stack(k_p), jnp.stack(v_p),
            jnp.stack(conv_s), jnp.stack(k_s), jnp.stack(v_s))
```

```cpp
#include <hip/hip_runtime.h>
#include <hip/hip_cooperative_groups.h>
#include <cstdio>
#include <cstdint>
namespace cg = cooperative_groups;

constexpr int DM = 2048, NB = 4, SEQ = 2048, NMETA = 16, LP = SEQ + NMETA, DECB = 32, DECT = 4;
constexpr int MP = NB * LP  , MS = DECB * DECT  , MV = MP + MS  , MPAD = 8448;
constexpr int DCONV = 1024, HD = 64, NH = 16, NKV = 4, QDIM = 1024, KVDIM = 256, DFF = 5504, DIN = 8704, NWIN = 128;
constexpr int ZO_XC = 0, ZO_BG = 1024, ZO_CG = 2048, ZO_Q = 3072, ZO_K = 4096, ZO_V = 4352, ZO_GC = 4608, ZO_GA = 6656;
constexpr float EPSN = 1e-6f;
constexpr size_t OUT_YP = 0, OUT_YS = 16777216, OUT_CP = 17039360, OUT_KP = 17047552, OUT_VP = 17178624, OUT_CS = 17309696, OUT_KS = 17375232, OUT_VS = 18423808, OUT_END = 19472384;

typedef unsigned short bf16_t;
#define LAS __attribute__((address_space(3)))
typedef unsigned u32x4_t __attribute__((ext_vector_type(4)));
typedef unsigned u32x2_t __attribute__((ext_vector_type(2)));
typedef float f32x4_t __attribute__((ext_vector_type(4)));

__device__ __forceinline__ const float* x0_row(const float* xp, const float* xs, const float* meta, int row) {
    if (row >= MV) row = MV - 1;
    if (row >= MP) return xs + (size_t)(row - MP) * DM;
    const int b = row / LP, t = row - b * LP;
    return t < NMETA ? meta + (size_t)t * DM : xp + ((size_t)b * SEQ + (t - NMETA)) * DM;
}
__device__ __forceinline__ float* y_row(float* out, int row) {
    if (row >= MV) return nullptr;
    if (row >= MP) return out + OUT_YS + (size_t)(row - MP) * DM;
    const int b = row / LP, t = row - b * LP;
    if (t < NMETA) return nullptr;
    return out + OUT_YP + ((size_t)b * SEQ + (t - NMETA)) * DM;
}
__device__ __forceinline__ float bf_lo(unsigned w) { return __uint_as_float(w << 16); }
__device__ __forceinline__ float bf_hi(unsigned w) { return __uint_as_float(w & 0xffff0000u); }

namespace pg8 {
#define PG8_LAS __attribute__((address_space(3)))
typedef unsigned short bf16_t;
typedef short bf16x8 __attribute__((ext_vector_type(8)));
typedef float f32x4 __attribute__((ext_vector_type(4)));
typedef unsigned u32x4 __attribute__((ext_vector_type(4)));
constexpr int BM = 256, BK = 64, HALF = 128, HTB = HALF * BK * 2  , STAGE_BYTES = 8 * HTB, NXCD = 8, WGM = 6;

__host__ __device__ __forceinline__ int lds_byte(int r, int c) { const int st = (r >> 4) * 2 + (c >> 5), rr = r & 15, cc = c & 31, ob = rr * 64 + cc * 2; return st * 1024 + (ob ^ (((ob >> 9) & 1) << 5)); }
__host__ __device__ __forceinline__ void stage_rc(int b, int& R, int& C) { const int st = b / 1024, sb = b % 1024, swz = sb ^ (((sb >> 9) & 1) << 5); R = (st >> 1) * 16 + swz / 64; C = (st & 1) * 32 + (swz % 64) / 2; }
__host__ __device__ __forceinline__ int perm32(int rho) { const int n = rho >> 4, i = rho & 15; return 8 * (i >> 2) + 4 * n + (i & 3); }

struct Unit { int pm, pn, k0, nk, part; };
struct Gemm { const bf16_t* A; const bf16_t* Bt; int M, N, K; float* part; int a_blk, b_blk; };

struct StaticOrder {
    int nM, nN, nwg, G, c, nkf;
    __host__ __device__ void init(int M, int N, int K, int G_, int c_) { nM = M / BM; nN = N / BM; nwg = nM * nN; G = G_; c = c_; nkf = K / BK; }
    __host__ __device__ bool next(int i, Unit& u) const {
        const long L = (long)i * G + c; const int xcd = (int)(L % NXCD), off = (int)(L / NXCD);
        const int b0 = xcd == 0 ? 0 : ((xcd * nwg / NXCD + WGM / 2) / WGM) * WGM, b1 = xcd == NXCD - 1 ? nwg : (((xcd + 1) * nwg / NXCD + WGM / 2) / WGM) * WGM;
        if (b0 + off >= b1) return false;
        const int wgid = b0 + off;
        const int nig = WGM * nN, gid = wgid / nig, fm = gid * WGM, gsz = (nM - fm) < WGM ? (nM - fm) : WGM;
        u.pm = fm + ((wgid % nig) % gsz); u.pn = (wgid % nig) / gsz; u.k0 = 0; u.nk = nkf; u.part = -1; return true;
    }
    __device__ __forceinline__ void a_ready(const Unit&) const {}
    __device__ __forceinline__ void done(const Unit&) const {}
};

struct TailOrder {
    int G, c, nkf, nsl, poff;
    __host__ __device__ void init(int K, int nsl_, int poff_, int G_, int c_) { G = G_; c = c_; nkf = K / BK; nsl = nsl_; poff = poff_; }
    __host__ __device__ bool next(int i, Unit& u) const {
        const long L = (long)i * G + c;
        if (L < 256) {
            const int xcd = (int)L % NXCD, off = (int)L / NXCD;
            u.pm = xcd * 4 + (off & 3); u.pn = off >> 2; u.k0 = 0; u.nk = nkf; u.part = -1; return true;
        }
        const long p = L - 256 - poff; if (p < 0 || p >= 8 * nsl) return false;
        const int sl = (int)p / 8, pairs = nkf / 2, base = pairs / nsl, rem = pairs % nsl;
        u.pm = 32; u.pn = (int)p % 8; u.k0 = 2 * (sl * base + (sl < rem ? sl : rem)); u.nk = 2 * (base + (sl < rem ? 1 : 0)); u.part = sl; return true;
    }
    __device__ __forceinline__ void a_ready(const Unit&) const {}
    __device__ __forceinline__ void done(const Unit&) const {}
};
__device__ __forceinline__ unsigned cvt_pk_bf16(float lo, float hi) { unsigned r; asm volatile("v_cvt_pk_bf16_f32 %0, %1, %2" : "=v"(r) : "v"(lo), "v"(hi)); return r; }
__device__ __forceinline__ float silu_mul(float g, float u) { return g * __builtin_amdgcn_rcpf(1.0f + __builtin_amdgcn_exp2f(-1.4426950408889634f * g)) * u; }
__device__ __forceinline__ float sigmoidf_(float v) { return __builtin_amdgcn_rcpf(1.0f + __builtin_amdgcn_exp2f(-1.4426950408889634f * v)); }

struct EpiSwiglu {
    static constexpr bool PERM = true, AFTER_DRAIN = false;
    bf16_t* act; const float* ss;
    __device__ __forceinline__ void operator()(const f32x4 (&acc)[2][2][4][2], const Unit& u, int wr, int wc, int fr, int fq) const {
        const int row0 = u.pm * BM + wr * 64 + fr, j0 = u.pn * HALF + wc * 32 + 8 * fq;
        float rs[2][4];
#pragma unroll
        for (int ai = 0; ai < 2; ++ai)
#pragma unroll
            for (int m = 0; m < 4; ++m) rs[ai][m] = ss[row0 + ai * HALF + m * 16];
        __builtin_amdgcn_sched_barrier(0);
#pragma unroll
        for (int ai = 0; ai < 2; ++ai)
#pragma unroll
            for (int m = 0; m < 4; ++m) {
                const int row = row0 + ai * HALF + m * 16;
                const float r = __builtin_amdgcn_rsqf(rs[ai][m] * (1.0f / DM) + EPSN);
                const f32x4 g0 = acc[ai][0][m][0] * r, g1 = acc[ai][0][m][1] * r, u0 = acc[ai][1][m][0] * r, u1 = acc[ai][1][m][1] * r;
                u32x4 w;
                w.x = cvt_pk_bf16(silu_mul(g0[0], u0[0]), silu_mul(g0[1], u0[1])); w.y = cvt_pk_bf16(silu_mul(g0[2], u0[2]), silu_mul(g0[3], u0[3]));
                w.z = cvt_pk_bf16(silu_mul(g1[0], u1[0]), silu_mul(g1[1], u1[1])); w.w = cvt_pk_bf16(silu_mul(g1[2], u1[2]), silu_mul(g1[3], u1[3]));
                *(u32x4*)(act + (((size_t)u.pm * (DFF / 64) + (u.pn * 2 + (wc >> 1))) * 256 + (row - u.pm * BM)) * 64 + (wc & 1) * 32 + 8 * fq) = w;
                __builtin_amdgcn_sched_barrier(0);
            }
    }
};

struct EpiZ {
    static constexpr bool PERM = true, AFTER_DRAIN = false;
    bf16_t* z; const float* ss;
    __device__ __forceinline__ void operator()(const f32x4 (&acc)[2][2][4][2], const Unit& u, int wr, int wc, int fr, int fq) const {
        const int row0 = u.pm * BM + wr * 64 + fr, col0 = u.pn * BM + wc * 32 + 8 * fq;
        const bool sig = (u.pn * BM >= ZO_GC);
        float rs[2][4];
#pragma unroll
        for (int ai = 0; ai < 2; ++ai)
#pragma unroll
            for (int m = 0; m < 4; ++m) rs[ai][m] = ss[row0 + ai * HALF + m * 16];
        __builtin_amdgcn_sched_barrier(0);
#pragma unroll
        for (int ai = 0; ai < 2; ++ai)
#pragma unroll
            for (int m = 0; m < 4; ++m) {
                const int row = row0 + ai * HALF + m * 16;
                const float r = __builtin_amdgcn_rsqf(rs[ai][m] * (1.0f / DM) + EPSN);
#pragma unroll
                for (int bj = 0; bj < 2; ++bj) {
                    f32x4 v0 = acc[ai][bj][m][0] * r, v1 = acc[ai][bj][m][1] * r;
                    if (sig) {
#pragma unroll
                        for (int i = 0; i < 4; ++i) { v0[i] = sigmoidf_(v0[i]); v1[i] = sigmoidf_(v1[i]); }
                    }
                    u32x4 w; w.x = cvt_pk_bf16(v0[0], v0[1]); w.y = cvt_pk_bf16(v0[2], v0[3]); w.z = cvt_pk_bf16(v1[0], v1[1]); w.w = cvt_pk_bf16(v1[2], v1[3]);
                    *(u32x4*)(z + (size_t)row * DIN + col0 + bj * HALF) = w;
                }
                __builtin_amdgcn_sched_barrier(0);
            }
    }
};

struct EpiGate {
    static constexpr bool PERM = true, AFTER_DRAIN = false;
    bf16_t* mixed; const bf16_t* z; int PASS;
    __device__ __forceinline__ void operator()(const f32x4 (&acc)[2][2][4][2], const Unit& u, int wr, int wc, int fr, int fq) const {
        const int row0 = u.pm * BM + wr * 64 + fr, col0 = u.pn * BM + wc * 32 + 8 * fq;
        const int zo = PASS ? ZO_GA : ZO_GC;
#pragma unroll
        for (int ai = 0; ai < 2; ++ai) {
            u32x4 gw[4][2], pw[4][2];
#pragma unroll
            for (int m = 0; m < 4; ++m)
#pragma unroll
                for (int bj = 0; bj < 2; ++bj) {
                    const int row = row0 + ai * HALF + m * 16, c = col0 + bj * HALF;
                    gw[m][bj] = *(const u32x4*)(z + (size_t)row * DIN + zo + c);
                    pw[m][bj] = PASS ? *(const u32x4*)(mixed + (size_t)row * DM + c) : (u32x4){0u, 0u, 0u, 0u};
                }
            __builtin_amdgcn_sched_barrier(0);
#pragma unroll
            for (int m = 0; m < 4; ++m) {
                const int row = row0 + ai * HALF + m * 16;
#pragma unroll
                for (int bj = 0; bj < 2; ++bj) {
                    const int c = col0 + bj * HALF;
                    const u32x4 g = gw[m][bj], p = pw[m][bj];
                    f32x4 v0 = acc[ai][bj][m][0], v1 = acc[ai][bj][m][1];
                    v0[0] = v0[0] * bf_lo(g.x) + bf_lo(p.x); v0[1] = v0[1] * bf_hi(g.x) + bf_hi(p.x); v0[2] = v0[2] * bf_lo(g.y) + bf_lo(p.y); v0[3] = v0[3] * bf_hi(g.y) + bf_hi(p.y);
                    v1[0] = v1[0] * bf_lo(g.z) + bf_lo(p.z); v1[1] = v1[1] * bf_hi(g.z) + bf_hi(p.z); v1[2] = v1[2] * bf_lo(g.w) + bf_lo(p.w); v1[3] = v1[3] * bf_hi(g.w) + bf_hi(p.w);
                    u32x4 w; w.x = cvt_pk_bf16(v0[0], v0[1]); w.y = cvt_pk_bf16(v0[2], v0[3]); w.z = cvt_pk_bf16(v1[0], v1[1]); w.w = cvt_pk_bf16(v1[2], v1[3]);
                    *(u32x4*)(mixed + (size_t)row * DM + c) = w;
                }
                __builtin_amdgcn_sched_barrier(0);
            }
        }
    }
};

template <int MODE> struct EpiResid {
    static constexpr bool PERM = false, AFTER_DRAIN = false;
    const float* xp; const float* xs; const float* meta; float* xbuf; bf16_t* xb; float* ss; float* out;
    __device__ __forceinline__ void operator()(const f32x4 (&acc)[2][2][4][2], const Unit& u, int wr, int wc, int fr, int fq) const {
        const int row0 = u.pm * BM + wr * 64 + fr, col0 = u.pn * BM + wc * 32 + 4 * fq;
        const float scale = (MODE == 1) ? 1.0f : 0.5f;
#pragma unroll
        for (int ai = 0; ai < 2; ++ai) {
            f32x4 bv[4][2][2];
#pragma unroll
            for (int m = 0; m < 4; ++m) {
                const int row = row0 + ai * HALF + m * 16;
                const float* base = (MODE == 0) ? x0_row(xp, xs, meta, row) : xbuf + (size_t)row * DM;
#pragma unroll
                for (int bj = 0; bj < 2; ++bj)
#pragma unroll
                    for (int n = 0; n < 2; ++n) bv[m][bj][n] = *(const f32x4*)(base + col0 + bj * HALF + n * 16);
            }
            __builtin_amdgcn_sched_barrier(0);
#pragma unroll
            for (int m = 0; m < 4; ++m) {
                const int row = row0 + ai * HALF + m * 16;
                float* dst = (MODE == 2) ? y_row(out, row) : xbuf + (size_t)row * DM;
                float sq = 0.f;
#pragma unroll
                for (int bj = 0; bj < 2; ++bj)
#pragma unroll
                    for (int n = 0; n < 2; ++n) {
                        const int c = col0 + bj * HALF + n * 16;
                        const f32x4 o = bv[m][bj][n] + acc[ai][bj][m][n] * scale;
                        if (MODE == 2) { if (dst) __builtin_nontemporal_store(o, (f32x4*)(dst + c)); }
                        else {
                            *(f32x4*)(dst + c) = o;
                            u32x2_t w; w.x = cvt_pk_bf16(o[0], o[1]); w.y = cvt_pk_bf16(o[2], o[3]);
                            *(u32x2_t*)(xb + (size_t)row * DM + c) = w;
                            sq += (o[0] * o[0] + o[1] * o[1]) + (o[2] * o[2] + o[3] * o[3]);
                        }
                    }
                if (MODE != 2) {
                    sq += __shfl_xor(sq, 16); sq += __shfl_xor(sq, 32);
                    if (fq == 0) __hip_atomic_fetch_add(ss + row, sq, __ATOMIC_RELAXED, __HIP_MEMORY_SCOPE_AGENT);
                }
                __builtin_amdgcn_sched_barrier(0);
            }
        }
    }
};

template <bool PERM> __device__ __forceinline__ void store_part(const f32x4 (&acc)[2][2][4][2], const Unit& u, float* part, int wr, int wc, int fr, int fq) {
    float* base = part + (size_t)u.part * (256 * 2048);
    int rl0 = wr * 64 + fr; const int col0 = u.pn * BM + wc * 32 + (PERM ? 8 * fq : 4 * fq);
    asm volatile("" : "+v"(rl0));
#pragma unroll
    for (int ai = 0; ai < 2; ++ai)
#pragma unroll
        for (int m = 0; m < 4; ++m) {
            float* rp = base + (size_t)(rl0 + ai * HALF + m * 16) * 2048 + col0;
#pragma unroll
            for (int bj = 0; bj < 2; ++bj)
#pragma unroll
                for (int n = 0; n < 2; ++n) *(f32x4*)(rp + bj * HALF + (PERM ? 4 * n : 16 * n)) = acc[ai][bj][m][n];
            __builtin_amdgcn_sched_barrier(0);
        }
}

template <class Epi, class Sched, bool ALIGN_EPI = false, bool SP2 = false>
__device__ __forceinline__ void gemm_phase(PG8_LAS unsigned char* lds, const Gemm g, const Sched& S, const Epi& E) {
    const int tid = threadIdx.x, wid = __builtin_amdgcn_readfirstlane(tid >> 6), lane = tid & 63, wr = wid >> 2, wc = wid & 3, fr = lane & 15, fq = lane >> 4;
    const int K = g.K;
    const int pitchA = g.a_blk ? BK : K, pitchB = g.b_blk ? BK : K;
    unsigned voffA[2], voffB[2];
#pragma unroll
    for (int i = 0; i < 2; ++i) { int R, C; stage_rc(tid * 16 + i * 8192, R, C); const int Rb = Epi::PERM ? ((R & ~31) + perm32(R & 31)) : R;
        voffA[i] = (unsigned)(R * pitchA + C) * 2u; voffB[i] = (unsigned)(Rb * pitchB + C) * 2u; }
    const size_t kstepA = g.a_blk ? (size_t)(BM * BK * 2) : (size_t)(BK * 2), kstepB = g.b_blk ? (size_t)(BM * BK * 2) : (size_t)(BK * 2);
    const size_t hstepA = (size_t)HALF * pitchA * 2, hstepB = (size_t)HALF * pitchB * 2;
    const size_t tstep = (size_t)BM * K * 2;
    const unsigned ldsw = (unsigned)wid * 1024u;
    const int aoff = lds_byte(wr * 64 + fr, fq * 8), boff = lds_byte(wc * 32 + fr, fq * 8);
#define PG8_SA(b, h) (((b) * 2 + (h)) * HTB)
#define PG8_SB(b, h) ((4 + (b) * 2 + (h)) * HTB)
#define PG8_STAGE(bufoff, gbase, voff) do { _Pragma("unroll") for (int _i = 0; _i < 2; ++_i) \
        __builtin_amdgcn_global_load_lds((const unsigned*)((const char*)(gbase) + (voff)[_i]), (PG8_LAS unsigned*)(lds + (bufoff) + ldsw + _i * 8192), 16, 0, 0); } while (0)
#define PG8_LDA(dst, b, h) do { _Pragma("unroll") for (int m = 0; m < 4; ++m) _Pragma("unroll") for (int k = 0; k < 2; ++k) dst[m][k] = *(const PG8_LAS bf16x8*)(lds + PG8_SA(b, h) + aoff + m * 2048 + k * 1024); } while (0)
#define PG8_LDB(dst, b, h) do { _Pragma("unroll") for (int n = 0; n < 2; ++n) _Pragma("unroll") for (int k = 0; k < 2; ++k) dst[n][k] = *(const PG8_LAS bf16x8*)(lds + PG8_SB(b, h) + boff + n * 2048 + k * 1024); } while (0)
#define PG8_MMA(ai, bj, At, Bt) do { __builtin_amdgcn_s_setprio(1); _Pragma("unroll") for (int m = 0; m < 4; ++m) _Pragma("unroll") for (int n = 0; n < 2; ++n) _Pragma("unroll") for (int k = 0; k < 2; ++k) \
        acc[ai][bj][m][n] = __builtin_amdgcn_mfma_f32_16x16x32_bf16(Bt[n][k], At[m][k], acc[ai][bj][m][n], 0, 0, 0); __builtin_amdgcn_s_setprio(0); } while (0)
#define PG8_WAIT_V(n) asm volatile("s_waitcnt vmcnt(" #n ")" ::: "memory")
#define PG8_WAIT_L(n) asm volatile("s_waitcnt lgkmcnt(" #n ")" ::: "memory")
#define PG8_BAR __builtin_amdgcn_s_barrier()
#define PG8_SCHED __builtin_amdgcn_sched_barrier(0)
    Unit cur, nxt; int ui = 0;
    if (!S.next(0, cur)) return;
    int nt = cur.nk;
    f32x4 acc[2][2][4][2];
#pragma unroll
    for (int a = 0; a < 2; ++a)
#pragma unroll
        for (int b = 0; b < 2; ++b)
#pragma unroll
            for (int m = 0; m < 4; ++m)
#pragma unroll
                for (int n = 0; n < 2; ++n) acc[a][b][m][n] = (f32x4){0.f, 0.f, 0.f, 0.f};
    bf16x8 At[4][2], B0[2][2], B1[2][2];
    const char* cA = (const char*)g.A + (size_t)cur.pm * tstep + (size_t)cur.k0 * kstepA; const char* cB = (const char*)g.Bt + (size_t)cur.pn * tstep + (size_t)cur.k0 * kstepB;
    S.a_ready(cur);
    if constexpr (SP2) {
        PG8_STAGE(PG8_SB(0, 0), cB, voffB); PG8_STAGE(PG8_SB(0, 1), cB + hstepB, voffB); PG8_STAGE(PG8_SA(0, 0), cA, voffA); PG8_STAGE(PG8_SA(0, 1), cA + hstepA, voffA);
        if (wr == 1) PG8_BAR;
        PG8_WAIT_V(2); PG8_BAR;
        PG8_STAGE(PG8_SB(1, 0), cB + kstepB, voffB); PG8_STAGE(PG8_SA(1, 0), cA + kstepA, voffA); PG8_STAGE(PG8_SB(1, 1), cB + hstepB + kstepB, voffB);
        PG8_WAIT_V(6); PG8_BAR;
    } else {
        PG8_STAGE(PG8_SB(0, 0), cB, voffB); PG8_STAGE(PG8_SA(0, 0), cA, voffA); PG8_STAGE(PG8_SB(0, 1), cB + hstepB, voffB); PG8_STAGE(PG8_SA(0, 1), cA + hstepA, voffA);
        if (wr == 1) PG8_BAR;
        PG8_WAIT_V(4); PG8_BAR;
        PG8_STAGE(PG8_SB(1, 0), cB + kstepB, voffB); PG8_STAGE(PG8_SA(1, 0), cA + kstepA, voffA); PG8_STAGE(PG8_SB(1, 1), cB + hstepB + kstepB, voffB);
        PG8_WAIT_V(6); PG8_BAR;
    }
    for (;;) {
        const bool has_next = S.next(ui + 1, nxt);
        const char* nA = has_next ? (const char*)g.A + (size_t)nxt.pm * tstep + (size_t)nxt.k0 * kstepA : cA; const char* nB = has_next ? (const char*)g.Bt + (size_t)nxt.pn * tstep + (size_t)nxt.k0 * kstepB : cB;
        for (int t = 0; t < nt; t += 2) {
            const bool last = (t == nt - 2);
            const char* a1 = cA + (size_t)(t + 1) * kstepA;
            const char* a2 = last ? nA : cA + (size_t)(t + 2) * kstepA; const char* b2 = last ? nB : cB + (size_t)(t + 2) * kstepB;
            const char* a3 = a2 + kstepA; const char* b3 = b2 + kstepB;
            if (last && has_next) S.a_ready(nxt);
            if constexpr (SP2) {
            PG8_LDB(B0, 0, 0); PG8_LDB(B1, 0, 1); PG8_SCHED; PG8_LDA(At, 0, 0); PG8_STAGE(PG8_SA(1, 1), a1 + hstepA, voffA);
            PG8_WAIT_V(8); PG8_WAIT_L(0); PG8_BAR; PG8_MMA(0, 0, At, B0); PG8_MMA(0, 1, At, B1); PG8_BAR; PG8_SCHED;
            PG8_LDA(At, 0, 1); PG8_STAGE(PG8_SB(0, 0), b2, voffB); PG8_STAGE(PG8_SB(0, 1), b2 + hstepB, voffB); PG8_STAGE(PG8_SA(0, 0), a2, voffA);
            PG8_WAIT_V(8); PG8_WAIT_L(0); PG8_BAR; PG8_MMA(1, 0, At, B0); PG8_MMA(1, 1, At, B1); PG8_BAR; PG8_SCHED;
            PG8_LDB(B0, 1, 0); PG8_LDB(B1, 1, 1); PG8_SCHED; PG8_LDA(At, 1, 0); PG8_STAGE(PG8_SA(0, 1), a2 + hstepA, voffA);
            PG8_WAIT_V(8); PG8_WAIT_L(0); PG8_BAR; PG8_MMA(0, 0, At, B0); PG8_MMA(0, 1, At, B1); PG8_BAR; PG8_SCHED;
            PG8_LDA(At, 1, 1); PG8_STAGE(PG8_SB(1, 0), b3, voffB); PG8_STAGE(PG8_SB(1, 1), b3 + hstepB, voffB); PG8_STAGE(PG8_SA(1, 0), a3, voffA);
            PG8_WAIT_V(8); PG8_WAIT_L(0); PG8_BAR; PG8_MMA(1, 0, At, B0); PG8_MMA(1, 1, At, B1); PG8_BAR; PG8_SCHED;
            } else {
            PG8_LDB(B0, 0, 0); PG8_SCHED; PG8_LDA(At, 0, 0); PG8_STAGE(PG8_SA(1, 1), a1 + hstepA, voffA);
            PG8_WAIT_L(8); PG8_BAR; PG8_WAIT_L(0); PG8_MMA(0, 0, At, B0); PG8_BAR; PG8_SCHED;
            PG8_LDB(B1, 0, 1); PG8_STAGE(PG8_SB(0, 0), b2, voffB);
            PG8_BAR; PG8_WAIT_L(0); PG8_MMA(0, 1, At, B1); PG8_BAR;
            PG8_LDA(At, 0, 1); PG8_STAGE(PG8_SA(0, 0), a2, voffA);
            PG8_BAR; PG8_WAIT_L(0); PG8_MMA(1, 0, At, B0); PG8_BAR; PG8_SCHED;
            PG8_STAGE(PG8_SB(0, 1), b2 + hstepB, voffB);
            PG8_WAIT_V(6); PG8_BAR; PG8_MMA(1, 1, At, B1); PG8_BAR;
            PG8_LDB(B0, 1, 0); PG8_SCHED; PG8_LDA(At, 1, 0); PG8_STAGE(PG8_SA(0, 1), a2 + hstepA, voffA);
            PG8_WAIT_L(8); PG8_BAR; PG8_WAIT_L(0); PG8_MMA(0, 0, At, B0); PG8_BAR; PG8_SCHED;
            PG8_LDB(B1, 1, 1); PG8_STAGE(PG8_SB(1, 0), b3, voffB);
            PG8_BAR; PG8_WAIT_L(0); PG8_MMA(0, 1, At, B1); PG8_BAR;
            PG8_LDA(At, 1, 1); PG8_STAGE(PG8_SA(1, 0), a3, voffA);
            PG8_BAR; PG8_WAIT_L(0); PG8_MMA(1, 0, At, B0); PG8_BAR; PG8_SCHED;
            PG8_STAGE(PG8_SB(1, 1), b3 + hstepB, voffB);
            PG8_WAIT_V(6); PG8_BAR; PG8_MMA(1, 1, At, B1); PG8_BAR;
            }
        }
        if constexpr (ALIGN_EPI) { if (wr == 0) PG8_BAR; }
        if constexpr (!Epi::AFTER_DRAIN) { if (cur.part < 0) E(acc, cur, wr, wc, fr, fq); else store_part<Epi::PERM>(acc, cur, g.part, wr, wc, fr, fq); S.done(cur); }
        if (!has_next) break;
#pragma unroll
        for (int a = 0; a < 2; ++a)
#pragma unroll
            for (int b = 0; b < 2; ++b)
#pragma unroll
                for (int m = 0; m < 4; ++m)
#pragma unroll
                    for (int n = 0; n < 2; ++n) acc[a][b][m][n] = (f32x4){0.f, 0.f, 0.f, 0.f};
        cur = nxt; cA = nA; cB = nB; ++ui; nt = cur.nk;
        if constexpr (ALIGN_EPI) { if (wr == 1) PG8_BAR; }
    }
    PG8_WAIT_V(0);
    if constexpr (!ALIGN_EPI) { if (wr == 0) PG8_BAR; }
    PG8_BAR;
    if constexpr (Epi::AFTER_DRAIN) { E.fused(acc, cur, wr, wc, fr, fq, lds, wid, lane); S.done(cur); }
#undef PG8_SA
#undef PG8_SB
#undef PG8_STAGE
#undef PG8_LDA
#undef PG8_LDB
#undef PG8_MMA
#undef PG8_WAIT_V
#undef PG8_WAIT_L
#undef PG8_BAR
#undef PG8_SCHED
}
}

constexpr int NWAVES = 8;
#ifndef PROBE_DUP
#define PROBE_DUP 0
#endif
#ifndef MK_N_LAUNCHES
#define MK_N_LAUNCHES 1
#endif
constexpr int N_PHASES = 13;
constexpr int TAIL0 = 8192, NTAIL = MV - TAIL0;
constexpr int LDS_BYTES = 147456;
constexpr int LDS_MISC_OFF = 135168;
typedef short bf16x8_t __attribute__((ext_vector_type(8)));

#define XB_TMO      128
#define XB_XCNT(j)  (256  + 64 * (j))
#define XB_XSUB(j)  (1280 + 64 * (j))
#define XB_XGEN(j)  (2304 + 64 * (j))
#define XB_TOP      3328
#define XB_TOPGEN   3392
#define XCD_BAR_WORDS 3456
#define XB_SPIN_CAP (1u << 18)

__device__ __forceinline__ unsigned xb_ld(unsigned* p)              { return __hip_atomic_load(p, __ATOMIC_RELAXED, __HIP_MEMORY_SCOPE_AGENT); }
__device__ __forceinline__ unsigned xb_add(unsigned* p, unsigned v) { return __hip_atomic_fetch_add(p, v, __ATOMIC_RELAXED, __HIP_MEMORY_SCOPE_AGENT); }
__device__ __forceinline__ unsigned xb_xcc_id() { return (unsigned)__builtin_amdgcn_s_getreg((3 << 11) | 20) & 0xFu; }
#define XB_SPIN(cond, bar) do { unsigned _sp = 0; while (cond) { __builtin_amdgcn_s_sleep(1); \
    if ((++_sp & 255u) == 0u) { if (xb_ld(&(bar)[XB_TMO])) break; if (_sp > XB_SPIN_CAP) { atomicAdd(&(bar)[XB_TMO], 1u); break; } } } } while (0)

struct XcdBarrier {
    unsigned* bar; unsigned x;
    volatile LAS unsigned* st;
};

__device__ __forceinline__ XcdBarrier xcd_barrier_post(unsigned* bar, volatile LAS unsigned* st) {
    XcdBarrier b; b.bar = bar; b.x = xb_xcc_id(); b.st = st;
    if (threadIdx.x == 0) (void)xb_add(&bar[XB_XCNT(b.x)], 1u);
    return b;
}
__device__ __forceinline__ void xcd_barrier_complete(unsigned* bar, unsigned x, unsigned& nloc, unsigned& nx) {
    const unsigned G = gridDim.x * gridDim.y * gridDim.z;
    unsigned sum, cnt, mine, sp = 0u;
    for (;;) {
        sum = 0u; cnt = 0u; mine = 0u;
#pragma unroll
        for (unsigned j = 0; j < 16; ++j) { const unsigned c = xb_ld(&bar[XB_XCNT(j)]); sum += c; cnt += (c > 0u) ? 1u : 0u; mine = (j == x) ? c : mine; }
        if (sum == G) break;
        __builtin_amdgcn_s_sleep(1);
        if ((++sp & 255u) == 0u) { if (xb_ld(&bar[XB_TMO])) break; if (sp > XB_SPIN_CAP) { atomicAdd(&bar[XB_TMO], 1u); break; } }
    }
    nloc = mine > 0u ? mine : 1u; nx = cnt > 0u ? cnt : 1u;
}

__device__ __forceinline__ void xcd_barrier(const XcdBarrier& b) {
    asm volatile("s_waitcnt vmcnt(0)" ::: "memory");
    __syncthreads();
    if (threadIdx.x == 0) {
        unsigned* bar = b.bar;
        __builtin_amdgcn_s_waitcnt(0);
        unsigned nloc = b.st[0], nx = b.st[1];
        if (nloc == 0u) { xcd_barrier_complete(bar, b.x, nloc, nx); b.st[0] = nloc; b.st[1] = nx; }
        const unsigned old = xb_add(&bar[XB_XSUB(b.x)], 1u);
        const unsigned gen = old / nloc;
        if (old + 1u == (gen + 1u) * nloc) {
            __builtin_amdgcn_fence(__ATOMIC_RELEASE, "agent");
            asm volatile("s_waitcnt vmcnt(0)" ::: "memory");
            const unsigned og = xb_add(&bar[XB_TOP], 1u);
            const unsigned tg = og / nx;
            if (og + 1u == (tg + 1u) * nx) xb_add(&bar[XB_TOPGEN], 1u);
            else XB_SPIN(xb_ld(&bar[XB_TOPGEN]) == tg, bar);
            __builtin_amdgcn_fence(__ATOMIC_ACQUIRE, "agent");
            xb_add(&bar[XB_XGEN(b.x)], 1u);
            asm volatile("s_waitcnt vmcnt(0)" ::: "memory");
        } else {
            XB_SPIN(xb_ld(&bar[XB_XGEN(b.x)]) == gen, bar);
            __builtin_amdgcn_fence(__ATOMIC_ACQUIRE, "agent");
            asm volatile("s_waitcnt vmcnt(0)" ::: "memory");
        }
    }
    __syncthreads();
}

#ifndef FLAT_BARRIER
#define FLAT_BARRIER 0
#endif
__device__ __forceinline__ void flat_barrier(unsigned* cnt) {
    asm volatile("s_waitcnt vmcnt(0)" ::: "memory");
    __syncthreads();
    if (threadIdx.x == 0) {
        const unsigned G = gridDim.x;
        __builtin_amdgcn_fence(__ATOMIC_RELEASE, "agent");
        asm volatile("s_waitcnt vmcnt(0)" ::: "memory");
        const unsigned old = __hip_atomic_fetch_add(cnt, 1u, __ATOMIC_RELAXED, __HIP_MEMORY_SCOPE_AGENT);
        const unsigned target = (old / G + 1u) * G;
        unsigned sp = 0u;
        while (__hip_atomic_load(cnt, __ATOMIC_RELAXED, __HIP_MEMORY_SCOPE_AGENT) < target) { __builtin_amdgcn_s_sleep(1); if (++sp > (1u << 24)) break; }
        __builtin_amdgcn_fence(__ATOMIC_ACQUIRE, "agent");
        asm volatile("s_waitcnt vmcnt(0)" ::: "memory");
    }
    __syncthreads();
}

constexpr size_t al256(size_t x) { return (x + 255) & ~(size_t)255; }
constexpr size_t WS_BAR = 0, BAR_ZERO_BYTES = 16384;
constexpr size_t WS_SS = 16384;
constexpr size_t WS_WUP1 = 262144;
constexpr size_t SZ_WUP = (size_t)2 * DFF * DM * 2, SZ_WDN = (size_t)DM * DFF * 2, SZ_WIN = (size_t)DIN * DM * 2, SZ_WC = (size_t)DM * DCONV * 2, SZ_WO = (size_t)DM * DM * 2;
constexpr size_t WS_WDN1 = WS_WUP1 + SZ_WUP, WS_WIN = WS_WDN1 + SZ_WDN, WS_WC = WS_WIN + SZ_WIN, WS_WA = WS_WC + SZ_WC, WS_WO = WS_WA + SZ_WC, WS_WUP2 = WS_WO + SZ_WO, WS_WDN2 = WS_WUP2 + SZ_WUP;
constexpr size_t WS_XB = WS_WDN2 + SZ_WDN;
constexpr size_t SZ_XB = (size_t)MPAD * DM * 2;
constexpr size_t WS_YA = WS_XB, WS_AT = WS_XB + SZ_XB / 2;
constexpr size_t WS_Z = WS_XB + SZ_XB;
constexpr size_t SZ_Z = (size_t)MPAD * DIN * 2;
constexpr size_t WS_ACT = WS_Z;
constexpr size_t WS_X1 = WS_Z + SZ_Z;
constexpr size_t WS_END = WS_X1 + (size_t)MPAD * DM * 4;
constexpr size_t WS_MIX = WS_WUP1;
static_assert(SZ_XB <= SZ_WUP && (size_t)MPAD * DFF * 2 <= SZ_Z, "aliases");

struct Args { const float* in[21]; float* out; unsigned char* ws; int ph_lo, ph_hi; };

__device__ __forceinline__ float wave_sum(float v) {
#pragma unroll
    for (int o = 1; o < 64; o <<= 1) v += __shfl_xor(v, o);
    return v;
}
__device__ __forceinline__ unsigned pk2(float lo, float hi) { return pg8::cvt_pk_bf16(lo, hi); }

__device__ __forceinline__ void p0_x_row(const float* xrow, bf16_t* orow, float* ssp, int lane, bool zero) {
    const f32x4_t* xr = (const f32x4_t*)xrow + lane;
    float s = 0.f; unsigned long long* o8 = (unsigned long long*)orow + lane;
#pragma unroll
    for (int j = 0; j < 8; ++j) {
        f32x4_t v = zero ? (f32x4_t){0.f, 0.f, 0.f, 0.f} : xr[64 * j];
        s += (v.x * v.x + v.y * v.y) + (v.z * v.z + v.w * v.w);
        o8[64 * j] = (unsigned long long)pk2(v.x, v.y) | ((unsigned long long)pk2(v.z, v.w) << 32);
    }
    s = wave_sum(s);
    if (lane == 0) *ssp = s;
}

constexpr int KS_PITCH = 72, VT_PITCH = 264, LDS_KS = 0, LDS_VT = 256 * KS_PITCH * 2;
constexpr float LOG2E = 1.4426950408889634f;

__device__ __forceinline__ void attn_head(const u32x4_t qa, const u32x4_t qc, int h, int iq, int qrow, int kb0, int smin, int smax, int r, int quad,
                                          const float* qg, const float* sinks, bf16_t* attn, LAS unsigned char* lds) {
    const float slope2 = __builtin_amdgcn_exp2f(-0.5f * (float)(h + 1)) * LOG2E, sink2 = sinks[h] * LOG2E;
    bf16x8_t qf[2];
    {
        float q0[8] = {bf_lo(qa.x), bf_hi(qa.x), bf_lo(qa.y), bf_hi(qa.y), bf_lo(qa.z), bf_hi(qa.z), bf_lo(qa.w), bf_hi(qa.w)};
        float q1[8] = {bf_lo(qc.x), bf_hi(qc.x), bf_lo(qc.y), bf_hi(qc.y), bf_lo(qc.z), bf_hi(qc.z), bf_lo(qc.w), bf_hi(qc.w)};
        float ssq = 0.f;
#pragma unroll
        for (int i = 0; i < 8; ++i) ssq += q0[i] * q0[i] + q1[i] * q1[i];
        ssq += __shfl_xor(ssq, 16); ssq += __shfl_xor(ssq, 32);
        const float rq = __builtin_amdgcn_rsqf(ssq * (1.0f / HD) + EPSN) * (0.125f * LOG2E);
        const f32x4_t g0a = *(const f32x4_t*)(qg + 8 * quad), g0b = *(const f32x4_t*)(qg + 8 * quad + 4), g1a = *(const f32x4_t*)(qg + 32 + 8 * quad), g1b = *(const f32x4_t*)(qg + 32 + 8 * quad + 4);
        u32x4_t p0, p1;
        p0.x = pk2(q0[0] * rq * g0a.x, q0[1] * rq * g0a.y); p0.y = pk2(q0[2] * rq * g0a.z, q0[3] * rq * g0a.w); p0.z = pk2(q0[4] * rq * g0b.x, q0[5] * rq * g0b.y); p0.w = pk2(q0[6] * rq * g0b.z, q0[7] * rq * g0b.w);
        p1.x = pk2(q1[0] * rq * g1a.x, q1[1] * rq * g1a.y); p1.y = pk2(q1[2] * rq * g1a.z, q1[3] * rq * g1a.w); p1.z = pk2(q1[4] * rq * g1b.x, q1[5] * rq * g1b.y); p1.w = pk2(q1[6] * rq * g1b.z, q1[7] * rq * g1b.w);
        qf[0] = __builtin_bit_cast(bf16x8_t, p0); qf[1] = __builtin_bit_cast(bf16x8_t, p1);
    }
    f32x4_t sc[10];
    const LAS unsigned char* kbase = lds + LDS_KS + (kb0 * 16 + r) * (KS_PITCH * 2) + quad * 16;
    float mx = -1e30f;
    const unsigned srange = (unsigned)(smax - smin);
#pragma unroll
    for (int kk = 0; kk < 9; ++kk) {
        const bf16x8_t k0 = *(const LAS bf16x8_t*)(kbase + kk * 16 * (KS_PITCH * 2)), k1 = *(const LAS bf16x8_t*)(kbase + kk * 16 * (KS_PITCH * 2) + 64);
        f32x4_t a = (f32x4_t){0.f, 0.f, 0.f, 0.f};
        a = __builtin_amdgcn_mfma_f32_16x16x32_bf16(k0, qf[0], a, 0, 0, 0);
        a = __builtin_amdgcn_mfma_f32_16x16x32_bf16(k1, qf[1], a, 0, 0, 0);
#pragma unroll
        for (int v = 0; v < 4; ++v) {
            const int s = 16 * (kb0 + kk) + 4 * quad + v, dist = 128 + iq - s;
            const bool ok = ((unsigned)dist <= 128u) && ((unsigned)(s - smin) < srange);
            const float x = ok ? a[v] - slope2 * (float)dist : -1e30f;
            a[v] = x; mx = fmaxf(mx, x);
        }
        sc[kk] = a;
        __builtin_amdgcn_sched_barrier(0);
    }
    mx = fmaxf(mx, __shfl_xor(mx, 16)); mx = fmaxf(mx, __shfl_xor(mx, 32)); mx = fmaxf(mx, sink2);
    float sum = 0.f;
#pragma unroll
    for (int kk = 0; kk < 9; ++kk)
#pragma unroll
        for (int v = 0; v < 4; ++v) { const float p = __builtin_amdgcn_exp2f(sc[kk][v] - mx); sc[kk][v] = p; sum += p; }
    sc[9] = (f32x4_t){0.f, 0.f, 0.f, 0.f};
    sum += __shfl_xor(sum, 16); sum += __shfl_xor(sum, 32);
    sum += __builtin_amdgcn_exp2f(sink2 - mx);
    const float inv = 1.0f / sum;
    f32x4_t o[4] = {(f32x4_t){0.f, 0.f, 0.f, 0.f}, (f32x4_t){0.f, 0.f, 0.f, 0.f}, (f32x4_t){0.f, 0.f, 0.f, 0.f}, (f32x4_t){0.f, 0.f, 0.f, 0.f}};
    const LAS unsigned char* vbase = lds + LDS_VT + (r * VT_PITCH + 16 * kb0 + 4 * quad) * 2;
#pragma unroll
    for (int ks = 0; ks < 5; ++ks) {
        u32x4_t pw; pw.x = pk2(sc[2 * ks][0], sc[2 * ks][1]); pw.y = pk2(sc[2 * ks][2], sc[2 * ks][3]); pw.z = pk2(sc[2 * ks + 1][0], sc[2 * ks + 1][1]); pw.w = pk2(sc[2 * ks + 1][2], sc[2 * ks + 1][3]);
        const bf16x8_t pf = __builtin_bit_cast(bf16x8_t, pw);
#pragma unroll
        for (int db = 0; db < 4; ++db) {
            const LAS unsigned char* vp = vbase + (db * 16 * VT_PITCH + 32 * ks) * 2;
            const u32x2_t lo2 = *(const LAS u32x2_t*)vp, hi2 = *(const LAS u32x2_t*)(vp + (ks < 4 ? 32 : 0));
            const u32x4_t vw = (u32x4_t){lo2.x, lo2.y, hi2.x, hi2.y};
            o[db] = __builtin_amdgcn_mfma_f32_16x16x32_bf16(__builtin_bit_cast(bf16x8_t, vw), pf, o[db], 0, 0, 0);
        }
        __builtin_amdgcn_sched_barrier(0);
    }
    bf16_t* op = attn + (size_t)qrow * QDIM + h * HD + 4 * quad;
#pragma unroll
    for (int db = 0; db < 4; ++db) { u32x2_t wv; wv.x = pk2(o[db][0] * inv, o[db][1] * inv); wv.y = pk2(o[db][2] * inv, o[db][3] * inv); *(u32x2_t*)(op + 16 * db) = wv; }
}

__device__ __forceinline__ void attn_unit(int kind, int b, int kh, int j, const bf16_t* z, const float* cache_k, const float* cache_v,
                                          const float* qg, const float* kg, const float* sinks, bf16_t* attn, float* out, LAS unsigned char* lds) {
    const int tid = threadIdx.x, lane = tid & 63, w = tid >> 6;
    int r = lane & 15, quad = lane >> 4;
    asm volatile("" : "+v"(r), "+v"(quad));
    bool active; int iq, gl, qrow, smin, smax;
    if (kind == 0) { active = !(j == 0 && w < 7); iq = 16 * w + r; gl = 0; qrow = b * LP + 128 * j + iq - 112; smin = (j == 0) ? 240 : (j == 1 ? 112 : 0); smax = 256; }
    else { active = (w == 0); iq = r >> 2; gl = r & 3; qrow = MP + b * DECT + iq; smin = 0; smax = NWIN + DECT; }
    u32x4_t qa[4], qc[4];
#pragma unroll
    for (int p = 0; p < 4; ++p) { qa[p] = (u32x4_t){0u, 0u, 0u, 0u}; qc[p] = (u32x4_t){0u, 0u, 0u, 0u}; }
    if (active) {
#pragma unroll
        for (int p = 0; p < 4; ++p) if (kind == 0 || p == 0) {
            const bf16_t* zq = z + (size_t)qrow * DIN + ZO_Q + (kh * 4 + (kind == 0 ? p : gl)) * HD + 8 * quad;
            qa[p] = *(const u32x4_t*)zq; qc[p] = *(const u32x4_t*)(zq + 32);
        }
    }
    {
        const int s = tid >> 1, hf = tid & 1;
        bool valid, need_norm = true; int row = 0;
        if (kind == 0) { const int tk = 128 * (j - 1) + s - 112; valid = tk >= 0; row = b * LP + tk; }
        else { valid = s < NWIN + DECT; need_norm = (s >= NWIN); row = MP + b * DECT + (s - NWIN); }
        const bool from_cache = (kind == 1 && s < NWIN);
        size_t oo = 0; bool wr_out = false;
        if (kind == 0) { if (j == 16 && s >= 128) { oo = ((size_t)(b * NWIN + (s - 128)) * NKV + kh) * HD + 32 * hf; wr_out = true; } }
        else { if (s >= DECT && s < NWIN + DECT) { oo = ((size_t)(b * NWIN + (s - DECT)) * NKV + kh) * HD + 32 * hf; wr_out = true; } }
        const size_t coff = ((size_t)(b * NWIN + s) * NKV + kh) * HD + 32 * hf;
        float kv[32], vv[32];
        if (!valid) {
#pragma unroll
            for (int i = 0; i < 32; ++i) { kv[i] = 0.f; vv[i] = 0.f; }
        } else if (from_cache) {
            const f32x4_t* ck = (const f32x4_t*)(cache_k + coff); const f32x4_t* cv = (const f32x4_t*)(cache_v + coff);
#pragma unroll
            for (int i = 0; i < 8; ++i) { const f32x4_t a = ck[i], c = cv[i]; kv[4 * i] = a.x; kv[4 * i + 1] = a.y; kv[4 * i + 2] = a.z; kv[4 * i + 3] = a.w; vv[4 * i] = c.x; vv[4 * i + 1] = c.y; vv[4 * i + 2] = c.z; vv[4 * i + 3] = c.w; }
        } else {
            const u32x4_t* zk = (const u32x4_t*)(z + (size_t)row * DIN + ZO_K + kh * HD + 32 * hf); const u32x4_t* zv = (const u32x4_t*)(z + (size_t)row * DIN + ZO_V + kh * HD + 32 * hf);
#pragma unroll
            for (int i = 0; i < 4; ++i) { const u32x4_t a = zk[i], c = zv[i];
                kv[8 * i] = bf_lo(a.x); kv[8 * i + 1] = bf_hi(a.x); kv[8 * i + 2] = bf_lo(a.y); kv[8 * i + 3] = bf_hi(a.y); kv[8 * i + 4] = bf_lo(a.z); kv[8 * i + 5] = bf_hi(a.z); kv[8 * i + 6] = bf_lo(a.w); kv[8 * i + 7] = bf_hi(a.w);
                vv[8 * i] = bf_lo(c.x); vv[8 * i + 1] = bf_hi(c.x); vv[8 * i + 2] = bf_lo(c.y); vv[8 * i + 3] = bf_hi(c.y); vv[8 * i + 4] = bf_lo(c.z); vv[8 * i + 5] = bf_hi(c.z); vv[8 * i + 6] = bf_lo(c.w); vv[8 * i + 7] = bf_hi(c.w); }
        }
        float ssq = 0.f;
#pragma unroll
        for (int i = 0; i < 32; ++i) ssq += kv[i] * kv[i];
        ssq += __shfl_xor(ssq, 1);
        if (valid && need_norm) {
            const float rinv = __builtin_amdgcn_rsqf(ssq * (1.0f / HD) + EPSN);
#pragma unroll
            for (int i = 0; i < 8; ++i) { const f32x4_t gg = *(const f32x4_t*)(kg + 32 * hf + 4 * i);
                kv[4 * i] *= rinv * gg.x; kv[4 * i + 1] *= rinv * gg.y; kv[4 * i + 2] *= rinv * gg.z; kv[4 * i + 3] *= rinv * gg.w; }
        }
        if (wr_out) { float* ko = out + ((kind == 0) ? OUT_KP : OUT_KS) + oo; float* vo = out + ((kind == 0) ? OUT_VP : OUT_VS) + oo;
#pragma unroll
            for (int i = 0; i < 8; ++i) { ((f32x4_t*)ko)[i] = (f32x4_t){kv[4 * i], kv[4 * i + 1], kv[4 * i + 2], kv[4 * i + 3]}; ((f32x4_t*)vo)[i] = (f32x4_t){vv[4 * i], vv[4 * i + 1], vv[4 * i + 2], vv[4 * i + 3]}; } }
        LAS u32x4_t* kd = (LAS u32x4_t*)(lds + LDS_KS + s * (KS_PITCH * 2) + hf * 64);
#pragma unroll
        for (int i = 0; i < 4; ++i) { u32x4_t o; o.x = pk2(kv[8 * i], kv[8 * i + 1]); o.y = pk2(kv[8 * i + 2], kv[8 * i + 3]); o.z = pk2(kv[8 * i + 4], kv[8 * i + 5]); o.w = pk2(kv[8 * i + 6], kv[8 * i + 7]); kd[i] = o; }
        LAS bf16_t* vt = (LAS bf16_t*)(lds + LDS_VT);
#pragma unroll
        for (int i = 0; i < 32; i += 2) { const unsigned p = pk2(vv[i], vv[i + 1]); vt[(32 * hf + i) * VT_PITCH + s] = (bf16_t)(p & 0xffffu); vt[(32 * hf + i + 1) * VT_PITCH + s] = (bf16_t)(p >> 16); }
    }
    __syncthreads();
    asm volatile("" : "+v"(iq));
    if (active) {
        const int kb0 = (kind == 0) ? w : 0;
#pragma unroll
        for (int p = 0; p < 4; ++p) if (kind == 0 || p == 0) {
            attn_head(qa[p], qc[p], kh * 4 + (kind == 0 ? p : gl), iq, qrow, kb0, smin, smax, r, quad, qg, sinks, attn, lds);
            __builtin_amdgcn_sched_barrier(0);
        }
    }
    __syncthreads();
}

__device__ __forceinline__ void load_u8(const bf16_t* z, int row, int c, float (&u)[8]) {
    const u32x4_t xc = *(const u32x4_t*)(z + (size_t)row * DIN + ZO_XC + c), cg_ = *(const u32x4_t*)(z + (size_t)row * DIN + ZO_CG + c);
    u[0] = bf_lo(xc.x) * bf_lo(cg_.x); u[1] = bf_hi(xc.x) * bf_hi(cg_.x); u[2] = bf_lo(xc.y) * bf_lo(cg_.y); u[3] = bf_hi(xc.y) * bf_hi(cg_.y);
    u[4] = bf_lo(xc.z) * bf_lo(cg_.z); u[5] = bf_hi(xc.z) * bf_hi(cg_.z); u[6] = bf_lo(xc.w) * bf_lo(cg_.w); u[7] = bf_hi(xc.w) * bf_hi(cg_.w);
}
__device__ __forceinline__ void load_f8(const float* p, float (&u)[8]) {
    const f32x4_t a = *(const f32x4_t*)p, b = *(const f32x4_t*)(p + 4);
    u[0] = a.x; u[1] = a.y; u[2] = a.z; u[3] = a.w; u[4] = b.x; u[5] = b.y; u[6] = b.z; u[7] = b.w;
}
__device__ __forceinline__ void conv_item(int ci, const bf16_t* z, const float* state, const float* cw, bf16_t* ya, float* out) {
    const int tid = threadIdx.x, c = (tid & 127) * 8, rsub = tid >> 7, rbase = 32 * ci + 8 * rsub;
    float w0[8], w1[8], w2[8];
    load_f8(cw + c, w0); load_f8(cw + DCONV + c, w1); load_f8(cw + 2 * DCONV + c, w2);
    u32x4_t xcw[10], cgw[10], bgw[8];
#pragma unroll
    for (int i = 0; i < 10; ++i) { const int row = rbase - 2 + i; const int rc = row < 0 ? 0 : row;
        xcw[i] = *(const u32x4_t*)(z + (size_t)rc * DIN + ZO_XC + c); cgw[i] = *(const u32x4_t*)(z + (size_t)rc * DIN + ZO_CG + c); }
#pragma unroll
    for (int i = 0; i < 8; ++i) bgw[i] = *(const u32x4_t*)(z + (size_t)(rbase + i) * DIN + ZO_BG + c);
    float u[10][8];
#pragma unroll
    for (int i = 0; i < 10; ++i) {
        const u32x4_t xc = xcw[i], cg_ = cgw[i];
        u[i][0] = bf_lo(xc.x) * bf_lo(cg_.x); u[i][1] = bf_hi(xc.x) * bf_hi(cg_.x); u[i][2] = bf_lo(xc.y) * bf_lo(cg_.y); u[i][3] = bf_hi(xc.y) * bf_hi(cg_.y);
        u[i][4] = bf_lo(xc.z) * bf_lo(cg_.z); u[i][5] = bf_hi(xc.z) * bf_hi(cg_.z); u[i][6] = bf_lo(xc.w) * bf_lo(cg_.w); u[i][7] = bf_hi(xc.w) * bf_hi(cg_.w);
    }
#pragma unroll
    for (int i = 0; i < 8; ++i) {
        const int row = rbase + i;
        int t, sq; const bool samp = row >= MP;
        if (!samp) { sq = row / LP; t = row - sq * LP; } else { sq = (row - MP) / DECT; t = (row - MP) - sq * DECT; }
        float u1[8], u2[8];
        if (t >= 1) {
#pragma unroll
            for (int e = 0; e < 8; ++e) u1[e] = u[i + 1][e];
        } else if (samp) load_f8(state + ((size_t)sq * 2 + 1) * DCONV + c, u1);
        else {
#pragma unroll
            for (int e = 0; e < 8; ++e) u1[e] = 0.f;
        }
        if (t >= 2) {
#pragma unroll
            for (int e = 0; e < 8; ++e) u2[e] = u[i][e];
        } else if (samp) load_f8(state + ((size_t)sq * 2 + t) * DCONV + c, u2);
        else {
#pragma unroll
            for (int e = 0; e < 8; ++e) u2[e] = 0.f;
        }
        const u32x4_t bw = bgw[i];
        const float bg[8] = {bf_lo(bw.x), bf_hi(bw.x), bf_lo(bw.y), bf_hi(bw.y), bf_lo(bw.z), bf_hi(bw.z), bf_lo(bw.w), bf_hi(bw.w)};
        float y[8];
#pragma unroll
        for (int e = 0; e < 8; ++e) y[e] = bg[e] * (w0[e] * u2[e] + w1[e] * u1[e] + w2[e] * u[i + 2][e]);
        u32x4_t o; o.x = pk2(y[0], y[1]); o.y = pk2(y[2], y[3]); o.z = pk2(y[4], y[5]); o.w = pk2(y[6], y[7]);
        *(u32x4_t*)(ya + (size_t)row * DCONV + c) = o;
        float* no = nullptr;
        if (!samp) { if (t >= LP - 2) no = out + OUT_CP + ((size_t)sq * 2 + (t - (LP - 2))) * DCONV + c; }
        else { if (t >= DECT - 2) no = out + OUT_CS + ((size_t)sq * 2 + (t - (DECT - 2))) * DCONV + c; }
        if (no) { *(f32x4_t*)no = (f32x4_t){u[i + 2][0], u[i + 2][1], u[i + 2][2], u[i + 2][3]}; *(f32x4_t*)(no + 4) = (f32x4_t){u[i + 2][4], u[i + 2][5], u[i + 2][6], u[i + 2][7]}; }
    }
}

template <int MODE> __device__ __forceinline__ void fix_resid(const float* part, int nsl, const float* xp, const float* xs, const float* meta, float* xbuf, bf16_t* xb, float* ss, float* out, int gw, int ngw, int lane) {
    for (int it = gw; it < NTAIL * 8; it += ngw) {
        const int rloc = it >> 3, row = TAIL0 + rloc, col = (it & 7) * 256 + lane * 4;
        const float* p = part + (size_t)rloc * 2048 + col;
        f32x4_t v = (f32x4_t){0.f, 0.f, 0.f, 0.f};
#pragma unroll 8
        for (int s = 0; s < nsl; ++s) v += __builtin_nontemporal_load((const f32x4_t*)(p + (size_t)s * (256 * 2048)));
        const float scale = (MODE == 1) ? 1.0f : 0.5f;
        const float* base = (MODE == 0) ? x0_row(xp, xs, meta, row) : xbuf + (size_t)row * DM;
        const f32x4_t o = *(const f32x4_t*)(base + col) + v * scale;
        if (MODE == 2) { float* dst = y_row(out, row); if (dst) __builtin_nontemporal_store(o, (f32x4_t*)(dst + col)); }
        else {
            *(f32x4_t*)(xbuf + (size_t)row * DM + col) = o;
            u32x2_t w; w.x = pk2(o.x, o.y); w.y = pk2(o.z, o.w); *(u32x2_t*)(xb + (size_t)row * DM + col) = w;
            const float sq = wave_sum((o.x * o.x + o.y * o.y) + (o.z * o.z + o.w * o.w));
            if (lane == 0) __hip_atomic_fetch_add(ss + row, sq, __ATOMIC_RELAXED, __HIP_MEMORY_SCOPE_AGENT);
        }
    }
}
__device__ __forceinline__ void fix_gate(const float* part, int nsl, const bf16_t* z, bf16_t* mixed, int gw, int ngw, int lane) {
    for (int it = gw; it < NTAIL * 8; it += ngw) {
        const int rloc = it >> 3, row = TAIL0 + rloc, col = (it & 7) * 256 + lane * 4;
        const float* p = part + (size_t)rloc * 2048 + col;
        f32x4_t a = (f32x4_t){0.f, 0.f, 0.f, 0.f}, b = (f32x4_t){0.f, 0.f, 0.f, 0.f};
#pragma unroll 8
        for (int s = 0; s < nsl; ++s) { a += __builtin_nontemporal_load((const f32x4_t*)(p + (size_t)s * (256 * 2048))); b += __builtin_nontemporal_load((const f32x4_t*)(p + (size_t)(s + nsl) * (256 * 2048))); }
        const u32x2_t gc = *(const u32x2_t*)(z + (size_t)row * DIN + ZO_GC + col), ga = *(const u32x2_t*)(z + (size_t)row * DIN + ZO_GA + col);
        u32x2_t w;
        w.x = pk2(bf_lo(gc.x) * a.x + bf_lo(ga.x) * b.x, bf_hi(gc.x) * a.y + bf_hi(ga.x) * b.y);
        w.y = pk2(bf_lo(gc.y) * a.z + bf_lo(ga.y) * b.z, bf_hi(gc.y) * a.w + bf_hi(ga.y) * b.w);
        *(u32x2_t*)(mixed + (size_t)row * DM + col) = w;
    }
}

constexpr int I_UP = (DM / 64) * (2 * DFF / 64), I_DN = (DFF / 64) * (DM / 64), I_IN = (DM / 64) * (DIN / 64), I_C = (DCONV / 64) * (DM / 64), I_O = (DM / 64) * (DM / 64);
constexpr int CI_DN1 = I_UP, CI_IN = CI_DN1 + I_DN, CI_C = CI_IN + I_IN, CI_A = CI_C + I_C, CI_O = CI_A + I_C, CI_UP2 = CI_O + I_O, CI_DN2 = CI_UP2 + I_UP, CI_END = CI_DN2 + I_DN;
struct CvtItem { const float* src; const float* gp; bf16_t* dst; int N, K; };
__device__ __forceinline__ void cvt_decode(int it, int lane, const Args& args, CvtItem& d) {
    const float* W; const float* gain = nullptr; int K, N, mode = 0, item, blk = 0; size_t wo;
    if (it < CI_DN1)      { W = args.in[7];  K = DM;    N = 2 * DFF; wo = WS_WUP1; gain = args.in[6];  mode = 1; item = it; blk = 1; }
    else if (it < CI_IN)  { W = args.in[8];  K = DFF;   N = DM;      wo = WS_WDN1; item = it - CI_DN1; blk = 1; }
    else if (it < CI_C)   { W = args.in[10]; K = DM;    N = DIN;     wo = WS_WIN;  gain = args.in[9];  item = it - CI_IN; blk = 1; }
    else if (it < CI_A)   { W = args.in[14]; K = DCONV; N = DM;      wo = WS_WC;   item = it - CI_C; }
    else if (it < CI_O)   { W = args.in[16]; K = QDIM;  N = DM;      wo = WS_WA;   item = it - CI_A; }
    else if (it < CI_UP2) { W = args.in[17]; K = DM;    N = DM;      wo = WS_WO;   item = it - CI_O; }
    else if (it < CI_DN2) { W = args.in[19]; K = DM;    N = 2 * DFF; wo = WS_WUP2; gain = args.in[18]; mode = 1; item = it - CI_UP2; blk = 1; }
    else                  { W = args.in[20]; K = DFF;   N = DM;      wo = WS_WDN2; item = it - CI_DN2; blk = 1; }
    const int nblk = N / 64, kb = item / nblk, nb = item - kb * nblk, k0 = 64 * kb, n0 = 64 * nb;
    int nd0 = n0;
    if (mode == 1) { if (n0 < DFF) nd0 = 256 * (n0 / 128) + (n0 % 128); else { const int j = n0 - DFF; nd0 = 256 * (j / 128) + 128 + (j % 128); } }
    d.src = W + (size_t)(k0 + (lane >> 4)) * N + n0 + (lane & 15) * 4;
    d.gp = gain ? gain + k0 + (lane >> 4) : nullptr;
    const int nrow = nd0 + (lane >> 3);
    if (blk) { d.dst = (bf16_t*)(args.ws + wo) + (((size_t)(nrow >> 8) * (K / 64) + kb) * 256 + (nrow & 255)) * 64 + 8 * (lane & 7); d.K = 64; }
    else { d.dst = (bf16_t*)(args.ws + wo) + (size_t)nrow * K + k0 + 8 * (lane & 7); d.K = K; }
    d.N = N;
}
__device__ __forceinline__ void cvt_load(const CvtItem& d, f32x4_t (&v)[16], float (&g)[16]) {
#pragma unroll
    for (int i = 0; i < 16; ++i) { v[i] = __builtin_nontemporal_load((const f32x4_t*)(d.src + (size_t)(4 * i) * d.N)); g[i] = d.gp ? d.gp[4 * i] : 1.0f; }
}
__device__ __forceinline__ void convert_range(int lo_it, int hi_it, int gw, int ngw, LAS unsigned char* lds, int wave, int lane_in, const Args& args) {
    int lane = lane_in; asm volatile("" : "+v"(lane));
    LAS float* scr = (LAS float*)(lds + wave * 16640);
    int it = lo_it + gw;
    if (it >= hi_it) return;
    CvtItem cur; f32x4_t v[16]; float g[16];
    cvt_decode(it, lane, args, cur); cvt_load(cur, v, g);
#pragma unroll 1
    for (;;) {
        const int itn = it + ngw; const bool more = itn < hi_it;
        CvtItem nxt = cur; f32x4_t vn[16]; float gn[16];
        if (more) { cvt_decode(itn, lane, args, nxt); cvt_load(nxt, vn, gn); }
        LAS float* d = scr + (lane >> 4) * 65 + (lane & 15) * 4;
#pragma unroll
        for (int i = 0; i < 16; ++i) { const f32x4_t x = v[i] * g[i]; LAS float* dd = d + (4 * i) * 65; dd[0] = x.x; dd[1] = x.y; dd[2] = x.z; dd[3] = x.w; }
        asm volatile("s_waitcnt lgkmcnt(0)" ::: "memory");
        const LAS float* s = scr + (8 * (lane & 7)) * 65 + (lane >> 3);
#pragma unroll
        for (int j = 0; j < 8; ++j) { const LAS float* sj = s + 8 * j;
            u32x4_t o; o.x = pk2(sj[0 * 65], sj[1 * 65]); o.y = pk2(sj[2 * 65], sj[3 * 65]); o.z = pk2(sj[4 * 65], sj[5 * 65]); o.w = pk2(sj[6 * 65], sj[7 * 65]);
            *(u32x4_t*)(cur.dst + (size_t)(8 * j) * cur.K) = o; }
        asm volatile("s_waitcnt lgkmcnt(0)" ::: "memory");
        if (!more) break;
        it = itn; cur = nxt;
#pragma unroll
        for (int i = 0; i < 16; ++i) { v[i] = vn[i]; g[i] = gn[i]; }
    }
}

__global__ void __launch_bounds__(NWAVES * 64, 2) fwd_megakernel(Args args) {
    extern __shared__ __attribute__((aligned(16))) unsigned char lds_raw[];
    LAS unsigned char* lds = (LAS unsigned char*)lds_raw;
    const int tid = threadIdx.x, lane = tid & 63, wave = __builtin_amdgcn_readfirstlane(tid >> 6);
    const int G = gridDim.x, bx = blockIdx.x;
    unsigned char* ws = args.ws;
    const float* x_prompt = args.in[0]; const float* x_sample = args.in[1]; const float* state_conv = args.in[2]; const float* cache_k = args.in[3]; const float* cache_v = args.in[4];
    const float* meta = args.in[5]; const float* g_ffn1 = args.in[6]; const float* w_up1 = args.in[7]; const float* w_dn1 = args.in[8]; const float* g_mix = args.in[9];
    const float* w_in = args.in[10]; const float* q_g = args.in[11]; const float* k_g = args.in[12]; const float* conv_w = args.in[13]; const float* w_conv_out = args.in[14];
    const float* sinks = args.in[15]; const float* w_attn_out = args.in[16]; const float* w_o = args.in[17]; const float* g_ffn2 = args.in[18]; const float* w_up2 = args.in[19]; const float* w_dn2 = args.in[20];
    float* out = args.out;
    float* ss0 = (float*)(ws + WS_SS); float* ss1 = ss0 + MPAD; float* ss2 = ss1 + MPAD;
    bf16_t* Wup1 = (bf16_t*)(ws + WS_WUP1); bf16_t* Wdn1 = (bf16_t*)(ws + WS_WDN1); bf16_t* Win = (bf16_t*)(ws + WS_WIN); bf16_t* Wc = (bf16_t*)(ws + WS_WC); bf16_t* Wa = (bf16_t*)(ws + WS_WA);
    bf16_t* Wo = (bf16_t*)(ws + WS_WO); bf16_t* Wup2 = (bf16_t*)(ws + WS_WUP2); bf16_t* Wdn2 = (bf16_t*)(ws + WS_WDN2);
    bf16_t* xb = (bf16_t*)(ws + WS_XB); bf16_t* ya = (bf16_t*)(ws + WS_YA); bf16_t* at = (bf16_t*)(ws + WS_AT); bf16_t* zb = (bf16_t*)(ws + WS_Z); bf16_t* act = (bf16_t*)(ws + WS_ACT);
    float* x1 = (float*)(ws + WS_X1); bf16_t* mixed = (bf16_t*)(ws + WS_MIX);
    const int lo = args.ph_lo, hi = args.ph_hi;
    const int GG_UP = (G >= 64) ? ((G - 16) & ~7) : G / 2, GG_IN = (G >= 64) ? ((G - 24) & ~7) : G / 2;
    if (hi > 1000) cg::this_grid().sync();
    if (tid < 2) ((volatile LAS unsigned*)(lds + LDS_MISC_OFF))[tid] = 0u;
    __syncthreads();
    XcdBarrier bar = xcd_barrier_post((unsigned*)(ws + WS_BAR), (volatile LAS unsigned*)(lds + LDS_MISC_OFF));
#ifndef PH_MASK
#define PH_MASK 0x1fff
#endif
#define IN(k) (((PH_MASK >> (k)) & 1) && lo <= (k) && (k) < hi)
#define SEAM(k) do { if (IN(k) && IN((k) + 1)) { if (FLAT_BARRIER) flat_barrier((unsigned*)(ws + WS_BAR) + 64); else xcd_barrier(bar); } } while (0)

    for (int rep_ = 0; rep_ < ((PROBE_DUP == 1) ? 2 : 1); ++rep_)
    if (IN(0)) {
        const int gw = bx * NWAVES + wave, NGW = G * NWAVES;
        convert_range(0, CI_DN1, gw, NGW, lds, wave, lane, args);
        for (int m = gw; m < MPAD; m += 2 * NGW) {
            const int m2 = m + NGW; const bool has2 = m2 < MPAD, za = m >= MV, zb_ = (!has2) || m2 >= MV;
            const f32x4_t* xa = (const f32x4_t*)x0_row(x_prompt, x_sample, meta, m) + lane;
            const f32x4_t* xc = (const f32x4_t*)x0_row(x_prompt, x_sample, meta, has2 ? m2 : m) + lane;
            f32x4_t va[8], vb[8];
#pragma unroll
            for (int j = 0; j < 8; ++j) { va[j] = za ? (f32x4_t){0.f, 0.f, 0.f, 0.f} : xa[64 * j]; vb[j] = zb_ ? (f32x4_t){0.f, 0.f, 0.f, 0.f} : xc[64 * j]; }
            float sa = 0.f, sb = 0.f;
            unsigned long long* oa = (unsigned long long*)(xb + (size_t)m * DM) + lane; unsigned long long* ob = (unsigned long long*)(xb + (size_t)(has2 ? m2 : m) * DM) + lane;
#pragma unroll
            for (int j = 0; j < 8; ++j) {
                sa += (va[j].x * va[j].x + va[j].y * va[j].y) + (va[j].z * va[j].z + va[j].w * va[j].w);
                sb += (vb[j].x * vb[j].x + vb[j].y * vb[j].y) + (vb[j].z * vb[j].z + vb[j].w * vb[j].w);
                oa[64 * j] = (unsigned long long)pk2(va[j].x, va[j].y) | ((unsigned long long)pk2(va[j].z, va[j].w) << 32);
                if (has2) ob[64 * j] = (unsigned long long)pk2(vb[j].x, vb[j].y) | ((unsigned long long)pk2(vb[j].z, vb[j].w) << 32);
            }
            sa = wave_sum(sa); sb = wave_sum(sb);
            if (lane == 0) { ss0[m] = sa; ss1[m] = 0.f; ss2[m] = 0.f; if (has2) { ss0[m2] = sb; ss1[m2] = 0.f; ss2[m2] = 0.f; } }
        }
    }
    SEAM(0);
    if (PROBE_DUP == 3) { for (int rep_ = 0; rep_ < 16; ++rep_) SEAM(0); }
    const int gw = bx * NWAVES + wave, NGW = G * NWAVES;
    float* part_o = out;
    float* part_w = (float*)(ws + WS_WDN1);
    for (int rep_ = 0; rep_ < ((PROBE_DUP == 4) ? 2 : 1); ++rep_)
    if (IN(1)) {
        if (bx < GG_UP) { pg8::Gemm g{xb, Wup1, MPAD, 2 * DFF, DM, nullptr, 0, 1}; pg8::StaticOrder S; S.init(MPAD, 2 * DFF, DM, GG_UP, bx);
            pg8::EpiSwiglu E{act, ss0};
            pg8::gemm_phase<pg8::EpiSwiglu, pg8::StaticOrder, true, true>(lds, g, S, E); }
        else convert_range(CI_DN1, CI_C, (bx - GG_UP) * NWAVES + wave, (G - GG_UP) * NWAVES, lds, wave, lane, args);
    }
    SEAM(1);
    if (IN(2)) {
        pg8::Gemm g{act, Wdn1, MPAD, DM, DFF, part_o, 1, 1}; pg8::TailOrder S; S.init(DFF, 32, 0, G, bx);
        pg8::EpiResid<0> E{x_prompt, x_sample, meta, x1, xb, ss1, out};
        pg8::gemm_phase<pg8::EpiResid<0>, pg8::TailOrder, true, true>(lds, g, S, E);
    }
    SEAM(2);
    if (IN(3)) fix_resid<0>(part_o, 32, x_prompt, x_sample, meta, x1, xb, ss1, out, gw, NGW, lane);
    SEAM(3);
    for (int rep_ = 0; rep_ < ((PROBE_DUP == 5) ? 2 : 1); ++rep_)
    if (IN(4)) {
        if (bx < GG_IN) { pg8::Gemm g{xb, Win, MPAD, DIN, DM, nullptr, 0, 1}; pg8::StaticOrder S; S.init(MPAD, DIN, DM, GG_IN, bx);
            pg8::EpiZ E{zb, ss1};
            pg8::gemm_phase<pg8::EpiZ, pg8::StaticOrder, true, true>(lds, g, S, E); }
        else convert_range(CI_C, CI_DN2, (bx - GG_IN) * NWAVES + wave, (G - GG_IN) * NWAVES, lds, wave, lane, args);
    }
    SEAM(4);
    for (int rep_ = 0; rep_ < ((PROBE_DUP == 2) ? 2 : 1); ++rep_)
    if (IN(5)) {
        constexpr int N_PH = NB * NKV * 16, N_PL = NB * NKV, N_SA = DECB * NKV, N_CV = MV / 32, N_IT = N_PH + N_PL + N_SA + N_CV;
        for (int it = bx; it < N_IT; it += G) {
            if (it < N_PH + N_PL) { const int bk = (it < N_PH) ? (it >> 4) : (it - N_PH), j = (it < N_PH) ? 1 + (it & 15) : 0; attn_unit(0, bk >> 2, bk & 3, j, zb, cache_k, cache_v, q_g, k_g, sinks, at, out, lds); }
            else if (it < N_PH + N_PL + N_SA) { const int u = it - N_PH - N_PL; attn_unit(1, u >> 2, u & 3, 0, zb, cache_k, cache_v, q_g, k_g, sinks, at, out, lds); }
            else conv_item(it - N_PH - N_PL - N_SA, zb, state_conv, conv_w, ya, out);
        }
    }
    SEAM(5);
    if (IN(6)) {
#pragma unroll 1
        for (int pass = 0; pass < 2; ++pass) {
            pg8::Gemm g{pass ? at : ya, pass ? Wa : Wc, MPAD, DM, DCONV, part_o + (size_t)pass * 8 * 256 * 2048, 0, 0}; pg8::TailOrder S; S.init(DCONV, 8, pass * 64, G, bx);
            pg8::EpiGate E{mixed, zb, pass};
            pg8::gemm_phase<pg8::EpiGate, pg8::TailOrder, true, true>(lds, g, S, E);
        }
    }
    SEAM(6);
    if (IN(7)) fix_gate(part_o, 8, zb, mixed, gw, NGW, lane);
    SEAM(7);
    if (IN(8)) {
        pg8::Gemm g{mixed, Wo, MPAD, DM, DM, part_o, 0, 0}; pg8::TailOrder S; S.init(DM, 16, 0, G, bx);
        pg8::EpiResid<1> E{x_prompt, x_sample, meta, x1, xb, ss2, out};
        pg8::gemm_phase<pg8::EpiResid<1>, pg8::TailOrder, true, true>(lds, g, S, E);
    }
    SEAM(8);
    if (IN(9)) fix_resid<1>(part_o, 16, x_prompt, x_sample, meta, x1, xb, ss2, out, gw, NGW, lane);
    SEAM(9);
    if (IN(10)) {
        if (bx < GG_UP) { pg8::Gemm g{xb, Wup2, MPAD, 2 * DFF, DM, nullptr, 0, 1}; pg8::StaticOrder S; S.init(MPAD, 2 * DFF, DM, GG_UP, bx);
            pg8::EpiSwiglu E{act, ss2};
            pg8::gemm_phase<pg8::EpiSwiglu, pg8::StaticOrder, true, true>(lds, g, S, E); }
        else convert_range(CI_DN2, CI_END, (bx - GG_UP) * NWAVES + wave, (G - GG_UP) * NWAVES, lds, wave, lane, args);
    }
    SEAM(10);
    for (int rep_ = 0; rep_ < ((PROBE_DUP == 6) ? 2 : 1); ++rep_) {
    if (rep_ == 1) { if (FLAT_BARRIER) flat_barrier((unsigned*)(ws + WS_BAR) + 64); else xcd_barrier(bar); }
    if (IN(11)) {
        pg8::Gemm g{act, Wdn2, MPAD, DM, DFF, part_w, 1, 1}; pg8::TailOrder S; S.init(DFF, 32, 0, G, bx);
        pg8::EpiResid<2> E{x_prompt, x_sample, meta, x1, xb, ss2, out};
        pg8::gemm_phase<pg8::EpiResid<2>, pg8::TailOrder, true, true>(lds, g, S, E);
    }
    SEAM(11);
    if (IN(12)) fix_resid<2>(part_w, 32, x_prompt, x_sample, meta, x1, xb, ss2, out, gw, NGW, lane);
    }
#undef IN
#undef SEAM
}

extern "C" void kernel_launch(void* const* d_in, const int* in_sizes, int n_in, void* d_out, int out_size, void* d_ws, size_t ws_size, hipStream_t stream) {
    static int grid = 0;
    if (grid == 0) {
        if (n_in != 21 || out_size != (int)OUT_END || ws_size < WS_END) { fprintf(stderr, "kernel_launch: unexpected shapes: n_in %d out %d ws %zu (need %zu)\n", n_in, out_size, ws_size, (size_t)WS_END); grid = -1; return; }
        int dev = 0, cus = 0, per_cu = 0;
        if (hipGetDevice(&dev) != hipSuccess || hipDeviceGetAttribute(&cus, hipDeviceAttributeMultiprocessorCount, dev) != hipSuccess) { grid = -1; return; }
        if (hipFuncSetAttribute((const void*)fwd_megakernel, hipFuncAttributeMaxDynamicSharedMemorySize, LDS_BYTES) != hipSuccess) { fprintf(stderr, "kernel_launch: hipFuncSetAttribute failed\n"); grid = -1; return; }
        if (hipOccupancyMaxActiveBlocksPerMultiprocessor(&per_cu, (const void*)fwd_megakernel, NWAVES * 64, LDS_BYTES) != hipSuccess || per_cu < 1) { fprintf(stderr, "kernel_launch: occupancy query says %d\n", per_cu); per_cu = 1; }
        (void)hipGetLastError();
        grid = cus;
    }
    if (grid < 0) return;
    if (hipMemsetAsync((char*)d_ws + WS_BAR, 0, BAR_ZERO_BYTES, stream) != hipSuccess) { fprintf(stderr, "kernel_launch: memset failed\n"); return; }
    Args a{};
    for (int i = 0; i < 21; ++i) a.in[i] = (const float*)d_in[i];
    a.out = (float*)d_out; a.ws = (unsigned char*)d_ws;
    if (MK_N_LAUNCHES == 1) {
        a.ph_lo = 0; a.ph_hi = N_PHASES;
        void* kargs[] = {&a};
        const hipError_t e = hipLaunchCooperativeKernel((const void*)fwd_megakernel, dim3(grid), dim3(NWAVES * 64), kargs, LDS_BYTES, stream);
        if (e != hipSuccess) fprintf(stderr, "kernel_launch: cooperative launch failed: %s (grid %d)\n", hipGetErrorString(e), grid);
    } else {
        for (int p = 0; p < N_PHASES; ++p) { a.ph_lo = p; a.ph_hi = p + 1; hipLaunchKernelGGL(fwd_megakernel, dim3(grid), dim3(NWAVES * 64), LDS_BYTES, stream, a); }
    }
}
```

```cpp
#include <hip/hip_runtime.h>
#include <hip/hip_cooperative_groups.h>
#include <cstdio>
#include <cstdint>
namespace cg = cooperative_groups;

constexpr int DM = 2048, NB = 4, SEQ = 2048, NMETA = 16, LP = SEQ + NMETA, DECB = 32, DECT = 4;
constexpr int MP = NB * LP  , MS = DECB * DECT  , MV = MP + MS  , MPAD = 8448;
constexpr int DCONV = 1024, HD = 64, NH = 16, NKV = 4, QDIM = 1024, KVDIM = 256, DFF = 5504, DIN = 8704, NWIN = 128;
constexpr int ZO_XC = 0, ZO_BG = 1024, ZO_CG = 2048, ZO_Q = 3072, ZO_K = 4096, ZO_V = 4352, ZO_GC = 4608, ZO_GA = 6656;
constexpr float EPSN = 1e-6f;
constexpr size_t OUT_YP = 0, OUT_YS = 16777216, OUT_CP = 17039360, OUT_KP = 17047552, OUT_VP = 17178624, OUT_CS = 17309696, OUT_KS = 17375232, OUT_VS = 18423808, OUT_END = 19472384;

typedef unsigned short bf16_t;
#define LAS __attribute__((address_space(3)))
typedef unsigned u32x4_t __attribute__((ext_vector_type(4)));
typedef unsigned u32x2_t __attribute__((ext_vector_type(2)));
typedef float f32x4_t __attribute__((ext_vector_type(4)));

__device__ __forceinline__ const float* x0_row(const float* xp, const float* xs, const float* meta, int row) {
    if (row >= MV) row = MV - 1;
    if (row >= MP) return xs + (size_t)(row - MP) * DM;
    const int b = row / LP, t = row - b * LP;
    return t < NMETA ? meta + (size_t)t * DM : xp + ((size_t)b * SEQ + (t - NMETA)) * DM;
}
__device__ __forceinline__ float* y_row(float* out, int row) {
    if (row >= MV) return nullptr;
    if (row >= MP) return out + OUT_YS + (size_t)(row - MP) * DM;
    const int b = row / LP, t = row - b * LP;
    if (t < NMETA) return nullptr;
    return out + OUT_YP + ((size_t)b * SEQ + (t - NMETA)) * DM;
}
__device__ __forceinline__ float bf_lo(unsigned w) { return __uint_as_float(w << 16); }
__device__ __forceinline__ float bf_hi(unsigned w) { return __uint_as_float(w & 0xffff0000u); }

namespace pg8 {
#define PG8_LAS __attribute__((address_space(3)))
typedef unsigned short bf16_t;
typedef short bf16x8 __attribute__((ext_vector_type(8)));
typedef float f32x4 __attribute__((ext_vector_type(4)));
typedef unsigned u32x4 __attribute__((ext_vector_type(4)));
constexpr int BM = 256, BK = 64, HALF = 128, HTB = HALF * BK * 2  , STAGE_BYTES = 8 * HTB, NXCD = 8, WGM = 6;

__host__ __device__ __forceinline__ int lds_byte(int r, int c) { const int st = (r >> 4) * 2 + (c >> 5), rr = r & 15, cc = c & 31, ob = rr * 64 + cc * 2; return st * 1024 + (ob ^ (((ob >> 9) & 1) << 5)); }
__host__ __device__ __forceinline__ void stage_rc(int b, int& R, int& C) { const int st = b / 1024, sb = b % 1024, swz = sb ^ (((sb >> 9) & 1) << 5); R = (st >> 1) * 16 + swz / 64; C = (st & 1) * 32 + (swz % 64) / 2; }
__host__ __device__ __forceinline__ int perm32(int rho) { const int n = rho >> 4, i = rho & 15; return 8 * (i >> 2) + 4 * n + (i & 3); }

struct Unit { int pm, pn, k0, nk, part; };
struct Gemm { const bf16_t* A; const bf16_t* Bt; int M, N, K; float* part; int a_blk, b_blk; };

struct StaticOrder {
    int nM, nN, nwg, G, c, nkf;
    __host__ __device__ void init(int M, int N, int K, int G_, int c_) { nM = M / BM; nN = N / BM; nwg = nM * nN; G = G_; c = c_; nkf = K / BK; }
    __host__ __device__ bool next(int i, Unit& u) const {
        const long L = (long)i * G + c; const int xcd = (int)(L % NXCD), off = (int)(L / NXCD);
        const int b0 = xcd == 0 ? 0 : ((xcd * nwg / NXCD + WGM / 2) / WGM) * WGM, b1 = xcd == NXCD - 1 ? nwg : (((xcd + 1) * nwg / NXCD + WGM / 2) / WGM) * WGM;
        if (b0 + off >= b1) return false;
        const int wgid = b0 + off;
        const int nig = WGM * nN, gid = wgid / nig, fm = gid * WGM, gsz = (nM - fm) < WGM ? (nM - fm) : WGM;
        u.pm = fm + ((wgid % nig) % gsz); u.pn = (wgid % nig) / gsz; u.k0 = 0; u.nk = nkf; u.part = -1; return true;
    }
    __device__ __forceinline__ void a_ready(const Unit&) const {}
    __device__ __forceinline__ void done(const Unit&) const {}
};

struct TailOrder {
    int G, c, nkf, nsl, poff;
    __host__ __device__ void init(int K, int nsl_, int poff_, int G_, int c_) { G = G_; c = c_; nkf = K / BK; nsl = nsl_; poff = poff_; }
    __host__ __device__ bool next(int i, Unit& u) const {
        const long L = (long)i * G + c;
        if (L < 256) {
            const int xcd = (int)L % NXCD, off = (int)L / NXCD;
            u.pm = xcd * 4 + (off & 3); u.pn = off >> 2; u.k0 = 0; u.nk = nkf; u.part = -1; return true;
        }
        const long p = L - 256 - poff; if (p < 0 || p >= 8 * nsl) return false;
        const int sl = (int)p / 8, pairs = nkf / 2, base = pairs / nsl, rem = pairs % nsl;
        u.pm = 32; u.pn = (int)p % 8; u.k0 = 2 * (sl * base + (sl < rem ? sl : rem)); u.nk = 2 * (base + (sl < rem ? 1 : 0)); u.part = sl; return true;
    }
    __device__ __forceinline__ void a_ready(const Unit&) const {}
    __device__ __forceinline__ void done(const Unit&) const {}
};
__device__ __forceinline__ unsigned cvt_pk_bf16(float lo, float hi) { unsigned r; asm volatile("v_cvt_pk_bf16_f32 %0, %1, %2" : "=v"(r) : "v"(lo), "v"(hi)); return r; }
__device__ __forceinline__ float silu_mul(float g, float u) { return g * __builtin_amdgcn_rcpf(1.0f + __builtin_amdgcn_exp2f(-1.4426950408889634f * g)) * u; }
__device__ __forceinline__ float sigmoidf_(float v) { return __builtin_amdgcn_rcpf(1.0f + __builtin_amdgcn_exp2f(-1.4426950408889634f * v)); }

struct EpiSwiglu {
    static constexpr bool PERM = true, AFTER_DRAIN = false;
    bf16_t* act; const float* ss;
    __device__ __forceinline__ void operator()(const f32x4 (&acc)[2][2][4][2], const Unit& u, int wr, int wc, int fr, int fq) const {
        const int row0 = u.pm * BM + wr * 64 + fr, j0 = u.pn * HALF + wc * 32 + 8 * fq;
        float rs[2][4];
#pragma unroll
        for (int ai = 0; ai < 2; ++ai)
#pragma unroll
            for (int m = 0; m < 4; ++m) rs[ai][m] = ss[row0 + ai * HALF + m * 16];
        __builtin_amdgcn_sched_barrier(0);
#pragma unroll
        for (int ai = 0; ai < 2; ++ai)
#pragma unroll
            for (int m = 0; m < 4; ++m) {
                const int row = row0 + ai * HALF + m * 16;
                const float r = __builtin_amdgcn_rsqf(rs[ai][m] * (1.0f / DM) + EPSN);
                const f32x4 g0 = acc[ai][0][m][0] * r, g1 = acc[ai][0][m][1] * r, u0 = acc[ai][1][m][0] * r, u1 = acc[ai][1][m][1] * r;
                u32x4 w;
                w.x = cvt_pk_bf16(silu_mul(g0[0], u0[0]), silu_mul(g0[1], u0[1])); w.y = cvt_pk_bf16(silu_mul(g0[2], u0[2]), silu_mul(g0[3], u0[3]));
                w.z = cvt_pk_bf16(silu_mul(g1[0], u1[0]), silu_mul(g1[1], u1[1])); w.w = cvt_pk_bf16(silu_mul(g1[2], u1[2]), silu_mul(g1[3], u1[3]));
                *(u32x4*)(act + (((size_t)u.pm * (DFF / 64) + (u.pn * 2 + (wc >> 1))) * 256 + (row - u.pm * BM)) * 64 + (wc & 1) * 32 + 8 * fq) = w;
                __builtin_amdgcn_sched_barrier(0);
            }
    }
};

struct EpiZ {
    static constexpr bool PERM = true, AFTER_DRAIN = false;
    bf16_t* z; const float* ss;
    __device__ __forceinline__ void operator()(const f32x4 (&acc)[2][2][4][2], const Unit& u, int wr, int wc, int fr, int fq) const {
        const int row0 = u.pm * BM + wr * 64 + fr, col0 = u.pn * BM + wc * 32 + 8 * fq;
        const bool sig = (u.pn * BM >= ZO_GC);
        float rs[2][4];
#pragma unroll
        for (int ai = 0; ai < 2; ++ai)
#pragma unroll
            for (int m = 0; m < 4; ++m) rs[ai][m] = ss[row0 + ai * HALF + m * 16];
        __builtin_amdgcn_sched_barrier(0);
#pragma unroll
        for (int ai = 0; ai < 2; ++ai)
#pragma unroll
            for (int m = 0; m < 4; ++m) {
                const int row = row0 + ai * HALF + m * 16;
                const float r = __builtin_amdgcn_rsqf(rs[ai][m] * (1.0f / DM) + EPSN);
#pragma unroll
                for (int bj = 0; bj < 2; ++bj) {
                    f32x4 v0 = acc[ai][bj][m][0] * r, v1 = acc[ai][bj][m][1] * r;
                    if (sig) {
#pragma unroll
                        for (int i = 0; i < 4; ++i) { v0[i] = sigmoidf_(v0[i]); v1[i] = sigmoidf_(v1[i]); }
                    }
                    u32x4 w; w.x = cvt_pk_bf16(v0[0], v0[1]); w.y = cvt_pk_bf16(v0[2], v0[3]); w.z = cvt_pk_bf16(v1[0], v1[1]); w.w = cvt_pk_bf16(v1[2], v1[3]);
                    *(u32x4*)(z + (size_t)row * DIN + col0 + bj * HALF) = w;
                }
                __builtin_amdgcn_sched_barrier(0);
            }
    }
};

struct EpiGate {
    static constexpr bool PERM = true, AFTER_DRAIN = false;
    bf16_t* mixed; const bf16_t* z; int PASS;
    __device__ __forceinline__ void operator()(const f32x4 (&acc)[2][2][4][2], const Unit& u, int wr, int wc, int fr, int fq) const {
        const int row0 = u.pm * BM + wr * 64 + fr, col0 = u.pn * BM + wc * 32 + 8 * fq;
        const int zo = PASS ? ZO_GA : ZO_GC;
#pragma unroll
        for (int ai = 0; ai < 2; ++ai) {
            u32x4 gw[4][2], pw[4][2];
#pragma unroll
            for (int m = 0; m < 4; ++m)
#pragma unroll
                for (int bj = 0; bj < 2; ++bj) {
                    const int row = row0 + ai * HALF + m * 16, c = col0 + bj * HALF;
                    gw[m][bj] = *(const u32x4*)(z + (size_t)row * DIN + zo + c);
                    pw[m][bj] = PASS ? *(const u32x4*)(mixed + (size_t)row * DM + c) : (u32x4){0u, 0u, 0u, 0u};
                }
            __builtin_amdgcn_sched_barrier(0);
#pragma unroll
            for (int m = 0; m < 4; ++m) {
                const int row = row0 + ai * HALF + m * 16;
#pragma unroll
                for (int bj = 0; bj < 2; ++bj) {
                    const int c = col0 + bj * HALF;
                    const u32x4 g = gw[m][bj], p = pw[m][bj];
                    f32x4 v0 = acc[ai][bj][m][0], v1 = acc[ai][bj][m][1];
                    v0[0] = v0[0] * bf_lo(g.x) + bf_lo(p.x); v0[1] = v0[1] * bf_hi(g.x) + bf_hi(p.x); v0[2] = v0[2] * bf_lo(g.y) + bf_lo(p.y); v0[3] = v0[3] * bf_hi(g.y) + bf_hi(p.y);
                    v1[0] = v1[0] * bf_lo(g.z) + bf_lo(p.z); v1[1] = v1[1] * bf_hi(g.z) + bf_hi(p.z); v1[2] = v1[2] * bf_lo(g.w) + bf_lo(p.w); v1[3] = v1[3] * bf_hi(g.w) + bf_hi(p.w);
                    u32x4 w; w.x = cvt_pk_bf16(v0[0], v0[1]); w.y = cvt_pk_bf16(v0[2], v0[3]); w.z = cvt_pk_bf16(v1[0], v1[1]); w.w = cvt_pk_bf16(v1[2], v1[3]);
                    *(u32x4*)(mixed + (size_t)row * DM + c) = w;
                }
                __builtin_amdgcn_sched_barrier(0);
            }
        }
    }
};

template <int MODE> struct EpiResid {
    static constexpr bool PERM = false, AFTER_DRAIN = false;
    const float* xp; const float* xs; const float* meta; float* xbuf; bf16_t* xb; float* ss; float* out;
    __device__ __forceinline__ void operator()(const f32x4 (&acc)[2][2][4][2], const Unit& u, int wr, int wc, int fr, int fq) const {
        const int row0 = u.pm * BM + wr * 64 + fr, col0 = u.pn * BM + wc * 32 + 4 * fq;
        const float scale = (MODE == 1) ? 1.0f : 0.5f;
#pragma unroll
        for (int ai = 0; ai < 2; ++ai) {
            f32x4 bv[4][2][2];
#pragma unroll
            for (int m = 0; m < 4; ++m) {
                const int row = row0 + ai * HALF + m * 16;
                const float* base = (MODE == 0) ? x0_row(xp, xs, meta, row) : xbuf + (size_t)row * DM;
#pragma unroll
                for (int bj = 0; bj < 2; ++bj)
#pragma unroll
                    for (int n = 0; n < 2; ++n) bv[m][bj][n] = *(const f32x4*)(base + col0 + bj * HALF + n * 16);
            }
            __builtin_amdgcn_sched_barrier(0);
#pragma unroll
            for (int m = 0; m < 4; ++m) {
                const int row = row0 + ai * HALF + m * 16;
                float* dst = (MODE == 2) ? y_row(out, row) : xbuf + (size_t)row * DM;
                float sq = 0.f;
#pragma unroll
                for (int bj = 0; bj < 2; ++bj)
#pragma unroll
                    for (int n = 0; n < 2; ++n) {
                        const int c = col0 + bj * HALF + n * 16;
                        const f32x4 o = bv[m][bj][n] + acc[ai][bj][m][n] * scale;
                        if (MODE == 2) { if (dst) __builtin_nontemporal_store(o, (f32x4*)(dst + c)); }
                        else {
                            *(f32x4*)(dst + c) = o;
                            u32x2_t w; w.x = cvt_pk_bf16(o[0], o[1]); w.y = cvt_pk_bf16(o[2], o[3]);
                            *(u32x2_t*)(xb + (size_t)row * DM + c) = w;
                            sq += (o[0] * o[0] + o[1] * o[1]) + (o[2] * o[2] + o[3] * o[3]);
                        }
                    }
                if (MODE != 2) {
                    sq += __shfl_xor(sq, 16); sq += __shfl_xor(sq, 32);
                    if (fq == 0) __hip_atomic_fetch_add(ss + row, sq, __ATOMIC_RELAXED, __HIP_MEMORY_SCOPE_AGENT);
                }
                __builtin_amdgcn_sched_barrier(0);
            }
        }
    }
};

template <bool PERM> __device__ __forceinline__ void store_part(const f32x4 (&acc)[2][2][4][2], const Unit& u, float* part, int wr, int wc, int fr, int fq) {
    bf16_t* base = (bf16_t*)part + (size_t)u.part * (256 * 2048);
    int rl0 = wr * 64 + fr; const int col0 = u.pn * BM + wc * 32 + (PERM ? 8 * fq : 4 * fq);
    asm volatile("" : "+v"(rl0));
#pragma unroll
    for (int ai = 0; ai < 2; ++ai)
#pragma unroll
        for (int m = 0; m < 4; ++m) {
            bf16_t* rp = base + (size_t)(rl0 + ai * HALF + m * 16) * 2048 + col0;
#pragma unroll
            for (int bj = 0; bj < 2; ++bj)
#pragma unroll
                for (int n = 0; n < 2; ++n) { const f32x4 v = acc[ai][bj][m][n]; u32x2_t w; w.x = cvt_pk_bf16(v[0], v[1]); w.y = cvt_pk_bf16(v[2], v[3]);
                    *(u32x2_t*)(rp + bj * HALF + (PERM ? 4 * n : 16 * n)) = w; }
            __builtin_amdgcn_sched_barrier(0);
        }
}

template <class Epi, class Sched, bool ALIGN_EPI = false, bool SP2 = false>
__device__ __forceinline__ void gemm_phase(PG8_LAS unsigned char* lds, const Gemm g, const Sched& S, const Epi& E) {
    const int tid = threadIdx.x, wid = __builtin_amdgcn_readfirstlane(tid >> 6), lane = tid & 63, wr = wid >> 2, wc = wid & 3, fr = lane & 15, fq = lane >> 4;
    const int K = g.K;
    const int pitchA = g.a_blk ? BK : K, pitchB = g.b_blk ? BK : K;
    unsigned voffA[2], voffB[2];
#pragma unroll
    for (int i = 0; i < 2; ++i) { int R, C; stage_rc(tid * 16 + i * 8192, R, C); const int Rb = Epi::PERM ? ((R & ~31) + perm32(R & 31)) : R;
        voffA[i] = (unsigned)(R * pitchA + C) * 2u; voffB[i] = (unsigned)(Rb * pitchB + C) * 2u; }
    const size_t kstepA = g.a_blk ? (size_t)(BM * BK * 2) : (size_t)(BK * 2), kstepB = g.b_blk ? (size_t)(BM * BK * 2) : (size_t)(BK * 2);
    const size_t hstepA = (size_t)HALF * pitchA * 2, hstepB = (size_t)HALF * pitchB * 2;
    const size_t tstep = (size_t)BM * K * 2;
    const unsigned ldsw = (unsigned)wid * 1024u;
    const int aoff = lds_byte(wr * 64 + fr, fq * 8), boff = lds_byte(wc * 32 + fr, fq * 8);
#define PG8_SA(b, h) (((b) * 2 + (h)) * HTB)
#define PG8_SB(b, h) ((4 + (b) * 2 + (h)) * HTB)
#define PG8_STAGE(bufoff, gbase, voff) do { _Pragma("unroll") for (int _i = 0; _i < 2; ++_i) \
        __builtin_amdgcn_global_load_lds((const unsigned*)((const char*)(gbase) + (voff)[_i]), (PG8_LAS unsigned*)(lds + (bufoff) + ldsw + _i * 8192), 16, 0, 0); } while (0)
#define PG8_LDA(dst, b, h) do { _Pragma("unroll") for (int m = 0; m < 4; ++m) _Pragma("unroll") for (int k = 0; k < 2; ++k) dst[m][k] = *(const PG8_LAS bf16x8*)(lds + PG8_SA(b, h) + aoff + m * 2048 + k * 1024); } while (0)
#define PG8_LDB(dst, b, h) do { _Pragma("unroll") for (int n = 0; n < 2; ++n) _Pragma("unroll") for (int k = 0; k < 2; ++k) dst[n][k] = *(const PG8_LAS bf16x8*)(lds + PG8_SB(b, h) + boff + n * 2048 + k * 1024); } while (0)
#define PG8_MMA(ai, bj, At, Bt) do { __builtin_amdgcn_s_setprio(1); _Pragma("unroll") for (int m = 0; m < 4; ++m) _Pragma("unroll") for (int n = 0; n < 2; ++n) _Pragma("unroll") for (int k = 0; k < 2; ++k) \
        acc[ai][bj][m][n] = __builtin_amdgcn_mfma_f32_16x16x32_bf16(Bt[n][k], At[m][k], acc[ai][bj][m][n], 0, 0, 0); __builtin_amdgcn_s_setprio(0); } while (0)
#define PG8_WAIT_V(n) asm volatile("s_waitcnt vmcnt(" #n ")" ::: "memory")
#define PG8_WAIT_L(n) asm volatile("s_waitcnt lgkmcnt(" #n ")" ::: "memory")
#define PG8_BAR __builtin_amdgcn_s_barrier()
#define PG8_SCHED __builtin_amdgcn_sched_barrier(0)
    Unit cur, nxt; int ui = 0;
    if (!S.next(0, cur)) return;
    int nt = cur.nk;
    f32x4 acc[2][2][4][2];
#pragma unroll
    for (int a = 0; a < 2; ++a)
#pragma unroll
        for (int b = 0; b < 2; ++b)
#pragma unroll
            for (int m = 0; m < 4; ++m)
#pragma unroll
                for (int n = 0; n < 2; ++n) acc[a][b][m][n] = (f32x4){0.f, 0.f, 0.f, 0.f};
    bf16x8 At[4][2], B0[2][2], B1[2][2];
    const char* cA = (const char*)g.A + (size_t)cur.pm * tstep + (size_t)cur.k0 * kstepA; const char* cB = (const char*)g.Bt + (size_t)cur.pn * tstep + (size_t)cur.k0 * kstepB;
    S.a_ready(cur);
    if constexpr (SP2) {
        PG8_STAGE(PG8_SB(0, 0), cB, voffB); PG8_STAGE(PG8_SB(0, 1), cB + hstepB, voffB); PG8_STAGE(PG8_SA(0, 0), cA, voffA); PG8_STAGE(PG8_SA(0, 1), cA + hstepA, voffA);
        if (wr == 1) PG8_BAR;
        PG8_WAIT_V(2); PG8_BAR;
        PG8_STAGE(PG8_SB(1, 0), cB + kstepB, voffB); PG8_STAGE(PG8_SA(1, 0), cA + kstepA, voffA); PG8_STAGE(PG8_SB(1, 1), cB + hstepB + kstepB, voffB);
        PG8_WAIT_V(6); PG8_BAR;
    } else {
        PG8_STAGE(PG8_SB(0, 0), cB, voffB); PG8_STAGE(PG8_SA(0, 0), cA, voffA); PG8_STAGE(PG8_SB(0, 1), cB + hstepB, voffB); PG8_STAGE(PG8_SA(0, 1), cA + hstepA, voffA);
        if (wr == 1) PG8_BAR;
        PG8_WAIT_V(4); PG8_BAR;
        PG8_STAGE(PG8_SB(1, 0), cB + kstepB, voffB); PG8_STAGE(PG8_SA(1, 0), cA + kstepA, voffA); PG8_STAGE(PG8_SB(1, 1), cB + hstepB + kstepB, voffB);
        PG8_WAIT_V(6); PG8_BAR;
    }
    for (;;) {
        const bool has_next = S.next(ui + 1, nxt);
        const char* nA = has_next ? (const char*)g.A + (size_t)nxt.pm * tstep + (size_t)nxt.k0 * kstepA : cA; const char* nB = has_next ? (const char*)g.Bt + (size_t)nxt.pn * tstep + (size_t)nxt.k0 * kstepB : cB;
        for (int t = 0; t < nt; t += 2) {
            const bool last = (t == nt - 2);
            const char* a1 = cA + (size_t)(t + 1) * kstepA;
            const char* a2 = last ? nA : cA + (size_t)(t + 2) * kstepA; const char* b2 = last ? nB : cB + (size_t)(t + 2) * kstepB;
            const char* a3 = a2 + kstepA; const char* b3 = b2 + kstepB;
            if (last && has_next) S.a_ready(nxt);
            if constexpr (SP2) {
            PG8_LDB(B0, 0, 0); PG8_LDB(B1, 0, 1); PG8_SCHED; PG8_LDA(At, 0, 0); PG8_STAGE(PG8_SA(1, 1), a1 + hstepA, voffA);
            PG8_WAIT_V(8); PG8_WAIT_L(0); PG8_BAR; PG8_MMA(0, 0, At, B0); PG8_MMA(0, 1, At, B1); PG8_BAR; PG8_SCHED;
            PG8_LDA(At, 0, 1); PG8_STAGE(PG8_SB(0, 0), b2, voffB); PG8_STAGE(PG8_SB(0, 1), b2 + hstepB, voffB); PG8_STAGE(PG8_SA(0, 0), a2, voffA);
            PG8_WAIT_V(8); PG8_WAIT_L(0); PG8_BAR; PG8_MMA(1, 0, At, B0); PG8_MMA(1, 1, At, B1); PG8_BAR; PG8_SCHED;
            PG8_LDB(B0, 1, 0); PG8_LDB(B1, 1, 1); PG8_SCHED; PG8_LDA(At, 1, 0); PG8_STAGE(PG8_SA(0, 1), a2 + hstepA, voffA);
            PG8_WAIT_V(8); PG8_WAIT_L(0); PG8_BAR; PG8_MMA(0, 0, At, B0); PG8_MMA(0, 1, At, B1); PG8_BAR; PG8_SCHED;
            PG8_LDA(At, 1, 1); PG8_STAGE(PG8_SB(1, 0), b3, voffB); PG8_STAGE(PG8_SB(1, 1), b3 + hstepB, voffB); PG8_STAGE(PG8_SA(1, 0), a3, voffA);
            PG8_WAIT_V(8); PG8_WAIT_L(0); PG8_BAR; PG8_MMA(1, 0, At, B0); PG8_MMA(1, 1, At, B1); PG8_BAR; PG8_SCHED;
            } else {
            PG8_LDB(B0, 0, 0); PG8_SCHED; PG8_LDA(At, 0, 0); PG8_STAGE(PG8_SA(1, 1), a1 + hstepA, voffA);
            PG8_WAIT_L(8); PG8_BAR; PG8_WAIT_L(0); PG8_MMA(0, 0, At, B0); PG8_BAR; PG8_SCHED;
            PG8_LDB(B1, 0, 1); PG8_STAGE(PG8_SB(0, 0), b2, voffB);
            PG8_BAR; PG8_WAIT_L(0); PG8_MMA(0, 1, At, B1); PG8_BAR;
            PG8_LDA(At, 0, 1); PG8_STAGE(PG8_SA(0, 0), a2, voffA);
            PG8_BAR; PG8_WAIT_L(0); PG8_MMA(1, 0, At, B0); PG8_BAR; PG8_SCHED;
            PG8_STAGE(PG8_SB(0, 1), b2 + hstepB, voffB);
            PG8_WAIT_V(6); PG8_BAR; PG8_MMA(1, 1, At, B1); PG8_BAR;
            PG8_LDB(B0, 1, 0); PG8_SCHED; PG8_LDA(At, 1, 0); PG8_STAGE(PG8_SA(0, 1), a2 + hstepA, voffA);
            PG8_WAIT_L(8); PG8_BAR; PG8_WAIT_L(0); PG8_MMA(0, 0, At, B0); PG8_BAR; PG8_SCHED;
            PG8_LDB(B1, 1, 1); PG8_STAGE(PG8_SB(1, 0), b3, voffB);
            PG8_BAR; PG8_WAIT_L(0); PG8_MMA(0, 1, At, B1); PG8_BAR;
            PG8_LDA(At, 1, 1); PG8_STAGE(PG8_SA(1, 0), a3, voffA);
            PG8_BAR; PG8_WAIT_L(0); PG8_MMA(1, 0, At, B0); PG8_BAR; PG8_SCHED;
            PG8_STAGE(PG8_SB(1, 1), b3 + hstepB, voffB);
            PG8_WAIT_V(6); PG8_BAR; PG8_MMA(1, 1, At, B1); PG8_BAR;
            }
        }
        if constexpr (ALIGN_EPI) { if (wr == 0) PG8_BAR; }
        if constexpr (!Epi::AFTER_DRAIN) { if (cur.part < 0) E(acc, cur, wr, wc, fr, fq); else store_part<Epi::PERM>(acc, cur, g.part, wr, wc, fr, fq); S.done(cur); }
        if (!has_next) break;
#pragma unroll
        for (int a = 0; a < 2; ++a)
#pragma unroll
            for (int b = 0; b < 2; ++b)
#pragma unroll
                for (int m = 0; m < 4; ++m)
#pragma unroll
                    for (int n = 0; n < 2; ++n) acc[a][b][m][n] = (f32x4){0.f, 0.f, 0.f, 0.f};
        cur = nxt; cA = nA; cB = nB; ++ui; nt = cur.nk;
        if constexpr (ALIGN_EPI) { if (wr == 1) PG8_BAR; }
    }
    PG8_WAIT_V(0);
    if constexpr (!ALIGN_EPI) { if (wr == 0) PG8_BAR; }
    PG8_BAR;
    if constexpr (Epi::AFTER_DRAIN) { E.fused(acc, cur, wr, wc, fr, fq, lds, wid, lane); S.done(cur); }
#undef PG8_SA
#undef PG8_SB
#undef PG8_STAGE
#undef PG8_LDA
#undef PG8_LDB
#undef PG8_MMA
#undef PG8_WAIT_V
#undef PG8_WAIT_L
#undef PG8_BAR
#undef PG8_SCHED
}
}

constexpr int NWAVES = 8;
#ifndef PROBE_DUP
#define PROBE_DUP 0
#endif
#ifndef MK_N_LAUNCHES
#define MK_N_LAUNCHES 1
#endif
constexpr int N_PHASES = 13;
constexpr int TAIL0 = 8192, NTAIL = MV - TAIL0;
constexpr int LDS_BYTES = 147456;
constexpr int LDS_MISC_OFF = 135168;
typedef short bf16x8_t __attribute__((ext_vector_type(8)));

#define XB_TMO      128
#define XB_XCNT(j)  (256  + 64 * (j))
#define XB_XSUB(j)  (1280 + 64 * (j))
#define XB_XGEN(j)  (2304 + 64 * (j))
#define XB_TOP      3328
#define XB_TOPGEN   3392
#define XCD_BAR_WORDS 3456
#define XB_SPIN_CAP (1u << 18)

__device__ __forceinline__ unsigned xb_ld(unsigned* p)              { return __hip_atomic_load(p, __ATOMIC_RELAXED, __HIP_MEMORY_SCOPE_AGENT); }
__device__ __forceinline__ unsigned xb_add(unsigned* p, unsigned v) { return __hip_atomic_fetch_add(p, v, __ATOMIC_RELAXED, __HIP_MEMORY_SCOPE_AGENT); }
__device__ __forceinline__ unsigned xb_xcc_id() { return (unsigned)__builtin_amdgcn_s_getreg((3 << 11) | 20) & 0xFu; }
#define XB_SPIN(cond, bar) do { unsigned _sp = 0; while (cond) { __builtin_amdgcn_s_sleep(1); \
    if ((++_sp & 255u) == 0u) { if (xb_ld(&(bar)[XB_TMO])) break; if (_sp > XB_SPIN_CAP) { atomicAdd(&(bar)[XB_TMO], 1u); break; } } } } while (0)

struct XcdBarrier {
    unsigned* bar; unsigned x;
    volatile LAS unsigned* st;
};

__device__ __forceinline__ XcdBarrier xcd_barrier_post(unsigned* bar, volatile LAS unsigned* st) {
    XcdBarrier b; b.bar = bar; b.x = xb_xcc_id(); b.st = st;
    if (threadIdx.x == 0) (void)xb_add(&bar[XB_XCNT(b.x)], 1u);
    return b;
}
__device__ __forceinline__ void xcd_barrier_complete(unsigned* bar, unsigned x, unsigned& nloc, unsigned& nx) {
    const unsigned G = gridDim.x * gridDim.y * gridDim.z;
    unsigned sum, cnt, mine, sp = 0u;
    for (;;) {
        sum = 0u; cnt = 0u; mine = 0u;
#pragma unroll
        for (unsigned j = 0; j < 16; ++j) { const unsigned c = xb_ld(&bar[XB_XCNT(j)]); sum += c; cnt += (c > 0u) ? 1u : 0u; mine = (j == x) ? c : mine; }
        if (sum == G) break;
        __builtin_amdgcn_s_sleep(1);
        if ((++sp & 255u) == 0u) { if (xb_ld(&bar[XB_TMO])) break; if (sp > XB_SPIN_CAP) { atomicAdd(&bar[XB_TMO], 1u); break; } }
    }
    nloc = mine > 0u ? mine : 1u; nx = cnt > 0u ? cnt : 1u;
}

__device__ __forceinline__ void xcd_barrier(const XcdBarrier& b) {
    asm volatile("s_waitcnt vmcnt(0)" ::: "memory");
    __syncthreads();
    if (threadIdx.x == 0) {
        unsigned* bar = b.bar;
        __builtin_amdgcn_s_waitcnt(0);
        unsigned nloc = b.st[0], nx = b.st[1];
        if (nloc == 0u) { xcd_barrier_complete(bar, b.x, nloc, nx); b.st[0] = nloc; b.st[1] = nx; }
        const unsigned old = xb_add(&bar[XB_XSUB(b.x)], 1u);
        const unsigned gen = old / nloc;
        if (old + 1u == (gen + 1u) * nloc) {
            __builtin_amdgcn_fence(__ATOMIC_RELEASE, "agent");
            asm volatile("s_waitcnt vmcnt(0)" ::: "memory");
            const unsigned og = xb_add(&bar[XB_TOP], 1u);
            const unsigned tg = og / nx;
            if (og + 1u == (tg + 1u) * nx) xb_add(&bar[XB_TOPGEN], 1u);
            else XB_SPIN(xb_ld(&bar[XB_TOPGEN]) == tg, bar);
            __builtin_amdgcn_fence(__ATOMIC_ACQUIRE, "agent");
            xb_add(&bar[XB_XGEN(b.x)], 1u);
            asm volatile("s_waitcnt vmcnt(0)" ::: "memory");
        } else {
            XB_SPIN(xb_ld(&bar[XB_XGEN(b.x)]) == gen, bar);
            __builtin_amdgcn_fence(__ATOMIC_ACQUIRE, "agent");
            asm volatile("s_waitcnt vmcnt(0)" ::: "memory");
        }
    }
    __syncthreads();
}

#ifndef FLAT_BARRIER
#define FLAT_BARRIER 0
#endif
__device__ __forceinline__ void flat_barrier(unsigned* cnt) {
    asm volatile("s_waitcnt vmcnt(0)" ::: "memory");
    __syncthreads();
    if (threadIdx.x == 0) {
        const unsigned G = gridDim.x;
        __builtin_amdgcn_fence(__ATOMIC_RELEASE, "agent");
        asm volatile("s_waitcnt vmcnt(0)" ::: "memory");
        const unsigned old = __hip_atomic_fetch_add(cnt, 1u, __ATOMIC_RELAXED, __HIP_MEMORY_SCOPE_AGENT);
        const unsigned target = (old / G + 1u) * G;
        unsigned sp = 0u;
        while (__hip_atomic_load(cnt, __ATOMIC_RELAXED, __HIP_MEMORY_SCOPE_AGENT) < target) { __builtin_amdgcn_s_sleep(1); if (++sp > (1u << 24)) break; }
        __builtin_amdgcn_fence(__ATOMIC_ACQUIRE, "agent");
        asm volatile("s_waitcnt vmcnt(0)" ::: "memory");
    }
    __syncthreads();
}

constexpr size_t al256(size_t x) { return (x + 255) & ~(size_t)255; }
constexpr size_t WS_BAR = 0, BAR_ZERO_BYTES = 16384;
constexpr size_t WS_SS = 16384;
constexpr size_t WS_WUP1 = 262144;
constexpr size_t SZ_WUP = (size_t)2 * DFF * DM * 2, SZ_WDN = (size_t)DM * DFF * 2, SZ_WIN = (size_t)DIN * DM * 2, SZ_WC = (size_t)DM * DCONV * 2, SZ_WO = (size_t)DM * DM * 2;
constexpr size_t WS_WDN1 = WS_WUP1 + SZ_WUP, WS_WIN = WS_WDN1 + SZ_WDN, WS_WC = WS_WIN + SZ_WIN, WS_WA = WS_WC + SZ_WC, WS_WO = WS_WA + SZ_WC, WS_WUP2 = WS_WO + SZ_WO, WS_WDN2 = WS_WUP2 + SZ_WUP;
constexpr size_t WS_XB = WS_WDN2 + SZ_WDN;
constexpr size_t SZ_XB = (size_t)MPAD * DM * 2;
constexpr size_t WS_YA = WS_XB, WS_AT = WS_XB + SZ_XB / 2;
constexpr size_t WS_Z = WS_XB + SZ_XB;
constexpr size_t SZ_Z = (size_t)MPAD * DIN * 2;
constexpr size_t WS_ACT = WS_Z;
constexpr size_t WS_X1 = WS_Z + SZ_Z;
constexpr size_t WS_END = WS_X1 + (size_t)MPAD * DM * 4;
constexpr size_t WS_MIX = WS_WUP1;
static_assert(SZ_XB <= SZ_WUP && (size_t)MPAD * DFF * 2 <= SZ_Z, "aliases");

struct Args { const float* in[21]; float* out; unsigned char* ws; int ph_lo, ph_hi; };

__device__ __forceinline__ float wave_sum(float v) {
#pragma unroll
    for (int o = 1; o < 64; o <<= 1) v += __shfl_xor(v, o);
    return v;
}
__device__ __forceinline__ unsigned pk2(float lo, float hi) { return pg8::cvt_pk_bf16(lo, hi); }

__device__ __forceinline__ void p0_x_row(const float* xrow, bf16_t* orow, float* ssp, int lane, bool zero) {
    const f32x4_t* xr = (const f32x4_t*)xrow + lane;
    float s = 0.f; unsigned long long* o8 = (unsigned long long*)orow + lane;
#pragma unroll
    for (int j = 0; j < 8; ++j) {
        f32x4_t v = zero ? (f32x4_t){0.f, 0.f, 0.f, 0.f} : xr[64 * j];
        s += (v.x * v.x + v.y * v.y) + (v.z * v.z + v.w * v.w);
        o8[64 * j] = (unsigned long long)pk2(v.x, v.y) | ((unsigned long long)pk2(v.z, v.w) << 32);
    }
    s = wave_sum(s);
    if (lane == 0) *ssp = s;
}

constexpr int KS_PITCH = 72, VT_PITCH = 264, LDS_KS = 0, LDS_VT = 256 * KS_PITCH * 2;
constexpr float LOG2E = 1.4426950408889634f;

__device__ __forceinline__ void attn_head(const u32x4_t qa, const u32x4_t qc, int h, int iq, int qrow, int kb0, int smin, int smax, int r, int quad,
                                          const float* qg, const float* sinks, bf16_t* attn, LAS unsigned char* lds) {
    const float slope2 = __builtin_amdgcn_exp2f(-0.5f * (float)(h + 1)) * LOG2E, sink2 = sinks[h] * LOG2E;
    bf16x8_t qf[2];
    {
        float q0[8] = {bf_lo(qa.x), bf_hi(qa.x), bf_lo(qa.y), bf_hi(qa.y), bf_lo(qa.z), bf_hi(qa.z), bf_lo(qa.w), bf_hi(qa.w)};
        float q1[8] = {bf_lo(qc.x), bf_hi(qc.x), bf_lo(qc.y), bf_hi(qc.y), bf_lo(qc.z), bf_hi(qc.z), bf_lo(qc.w), bf_hi(qc.w)};
        float ssq = 0.f;
#pragma unroll
        for (int i = 0; i < 8; ++i) ssq += q0[i] * q0[i] + q1[i] * q1[i];
        ssq += __shfl_xor(ssq, 16); ssq += __shfl_xor(ssq, 32);
        const float rq = __builtin_amdgcn_rsqf(ssq * (1.0f / HD) + EPSN) * (0.125f * LOG2E);
        const f32x4_t g0a = *(const f32x4_t*)(qg + 8 * quad), g0b = *(const f32x4_t*)(qg + 8 * quad + 4), g1a = *(const f32x4_t*)(qg + 32 + 8 * quad), g1b = *(const f32x4_t*)(qg + 32 + 8 * quad + 4);
        u32x4_t p0, p1;
        p0.x = pk2(q0[0] * rq * g0a.x, q0[1] * rq * g0a.y); p0.y = pk2(q0[2] * rq * g0a.z, q0[3] * rq * g0a.w); p0.z = pk2(q0[4] * rq * g0b.x, q0[5] * rq * g0b.y); p0.w = pk2(q0[6] * rq * g0b.z, q0[7] * rq * g0b.w);
        p1.x = pk2(q1[0] * rq * g1a.x, q1[1] * rq * g1a.y); p1.y = pk2(q1[2] * rq * g1a.z, q1[3] * rq * g1a.w); p1.z = pk2(q1[4] * rq * g1b.x, q1[5] * rq * g1b.y); p1.w = pk2(q1[6] * rq * g1b.z, q1[7] * rq * g1b.w);
        qf[0] = __builtin_bit_cast(bf16x8_t, p0); qf[1] = __builtin_bit_cast(bf16x8_t, p1);
    }
    f32x4_t sc[10];
    const LAS unsigned char* kbase = lds + LDS_KS + (kb0 * 16 + r) * (KS_PITCH * 2) + quad * 16;
    float mx = -1e30f;
    const unsigned srange = (unsigned)(smax - smin);
#pragma unroll
    for (int kk = 0; kk < 9; ++kk) {
        const bf16x8_t k0 = *(const LAS bf16x8_t*)(kbase + kk * 16 * (KS_PITCH * 2)), k1 = *(const LAS bf16x8_t*)(kbase + kk * 16 * (KS_PITCH * 2) + 64);
        f32x4_t a = (f32x4_t){0.f, 0.f, 0.f, 0.f};
        a = __builtin_amdgcn_mfma_f32_16x16x32_bf16(k0, qf[0], a, 0, 0, 0);
        a = __builtin_amdgcn_mfma_f32_16x16x32_bf16(k1, qf[1], a, 0, 0, 0);
#pragma unroll
        for (int v = 0; v < 4; ++v) {
            const int s = 16 * (kb0 + kk) + 4 * quad + v, dist = 128 + iq - s;
            const bool ok = ((unsigned)dist <= 128u) && ((unsigned)(s - smin) < srange);
            const float x = ok ? a[v] - slope2 * (float)dist : -1e30f;
            a[v] = x; mx = fmaxf(mx, x);
        }
        sc[kk] = a;
        __builtin_amdgcn_sched_barrier(0);
    }
    mx = fmaxf(mx, __shfl_xor(mx, 16)); mx = fmaxf(mx, __shfl_xor(mx, 32)); mx = fmaxf(mx, sink2);
    float sum = 0.f;
#pragma unroll
    for (int kk = 0; kk < 9; ++kk)
#pragma unroll
        for (int v = 0; v < 4; ++v) { const float p = __builtin_amdgcn_exp2f(sc[kk][v] - mx); sc[kk][v] = p; sum += p; }
    sc[9] = (f32x4_t){0.f, 0.f, 0.f, 0.f};
    sum += __shfl_xor(sum, 16); sum += __shfl_xor(sum, 32);
    sum += __builtin_amdgcn_exp2f(sink2 - mx);
    const float inv = 1.0f / sum;
    f32x4_t o[4] = {(f32x4_t){0.f, 0.f, 0.f, 0.f}, (f32x4_t){0.f, 0.f, 0.f, 0.f}, (f32x4_t){0.f, 0.f, 0.f, 0.f}, (f32x4_t){0.f, 0.f, 0.f, 0.f}};
    const LAS unsigned char* vbase = lds + LDS_VT + (r * VT_PITCH + 16 * kb0 + 4 * quad) * 2;
#pragma unroll
    for (int ks = 0; ks < 5; ++ks) {
        u32x4_t pw; pw.x = pk2(sc[2 * ks][0], sc[2 * ks][1]); pw.y = pk2(sc[2 * ks][2], sc[2 * ks][3]); pw.z = pk2(sc[2 * ks + 1][0], sc[2 * ks + 1][1]); pw.w = pk2(sc[2 * ks + 1][2], sc[2 * ks + 1][3]);
        const bf16x8_t pf = __builtin_bit_cast(bf16x8_t, pw);
#pragma unroll
        for (int db = 0; db < 4; ++db) {
            const LAS unsigned char* vp = vbase + (db * 16 * VT_PITCH + 32 * ks) * 2;
            const u32x2_t lo2 = *(const LAS u32x2_t*)vp, hi2 = *(const LAS u32x2_t*)(vp + (ks < 4 ? 32 : 0));
            const u32x4_t vw = (u32x4_t){lo2.x, lo2.y, hi2.x, hi2.y};
            o[db] = __builtin_amdgcn_mfma_f32_16x16x32_bf16(__builtin_bit_cast(bf16x8_t, vw), pf, o[db], 0, 0, 0);
        }
        __builtin_amdgcn_sched_barrier(0);
    }
    bf16_t* op = attn + (size_t)qrow * QDIM + h * HD + 4 * quad;
#pragma unroll
    for (int db = 0; db < 4; ++db) { u32x2_t wv; wv.x = pk2(o[db][0] * inv, o[db][1] * inv); wv.y = pk2(o[db][2] * inv, o[db][3] * inv); *(u32x2_t*)(op + 16 * db) = wv; }
}

__device__ __forceinline__ void attn_unit(int kind, int b, int kh, int j, const bf16_t* z, const float* cache_k, const float* cache_v,
                                          const float* qg, const float* kg, const float* sinks, bf16_t* attn, float* out, LAS unsigned char* lds) {
    const int tid = threadIdx.x, lane = tid & 63, w = tid >> 6;
    int r = lane & 15, quad = lane >> 4;
    asm volatile("" : "+v"(r), "+v"(quad));
    bool active; int iq, gl, qrow, smin, smax;
    if (kind == 0) { active = !(j == 0 && w < 7); iq = 16 * w + r; gl = 0; qrow = b * LP + 128 * j + iq - 112; smin = (j == 0) ? 240 : (j == 1 ? 112 : 0); smax = 256; }
    else { active = (w == 0); iq = r >> 2; gl = r & 3; qrow = MP + b * DECT + iq; smin = 0; smax = NWIN + DECT; }
    u32x4_t qa[4], qc[4];
#pragma unroll
    for (int p = 0; p < 4; ++p) { qa[p] = (u32x4_t){0u, 0u, 0u, 0u}; qc[p] = (u32x4_t){0u, 0u, 0u, 0u}; }
    if (active) {
#pragma unroll
        for (int p = 0; p < 4; ++p) if (kind == 0 || p == 0) {
            const bf16_t* zq = z + (size_t)qrow * DIN + ZO_Q + (kh * 4 + (kind == 0 ? p : gl)) * HD + 8 * quad;
            qa[p] = *(const u32x4_t*)zq; qc[p] = *(const u32x4_t*)(zq + 32);
        }
    }
    {
        const int s = tid >> 1, hf = tid & 1;
        bool valid, need_norm = true; int row = 0;
        if (kind == 0) { const int tk = 128 * (j - 1) + s - 112; valid = tk >= 0; row = b * LP + tk; }
        else { valid = s < NWIN + DECT; need_norm = (s >= NWIN); row = MP + b * DECT + (s - NWIN); }
        const bool from_cache = (kind == 1 && s < NWIN);
        size_t oo = 0; bool wr_out = false;
        if (kind == 0) { if (j == 16 && s >= 128) { oo = ((size_t)(b * NWIN + (s - 128)) * NKV + kh) * HD + 32 * hf; wr_out = true; } }
        else { if (s >= DECT && s < NWIN + DECT) { oo = ((size_t)(b * NWIN + (s - DECT)) * NKV + kh) * HD + 32 * hf; wr_out = true; } }
        const size_t coff = ((size_t)(b * NWIN + s) * NKV + kh) * HD + 32 * hf;
        float kv[32], vv[32];
        if (!valid) {
#pragma unroll
            for (int i = 0; i < 32; ++i) { kv[i] = 0.f; vv[i] = 0.f; }
        } else if (from_cache) {
            const f32x4_t* ck = (const f32x4_t*)(cache_k + coff); const f32x4_t* cv = (const f32x4_t*)(cache_v + coff);
#pragma unroll
            for (int i = 0; i < 8; ++i) { const f32x4_t a = ck[i], c = cv[i]; kv[4 * i] = a.x; kv[4 * i + 1] = a.y; kv[4 * i + 2] = a.z; kv[4 * i + 3] = a.w; vv[4 * i] = c.x; vv[4 * i + 1] = c.y; vv[4 * i + 2] = c.z; vv[4 * i + 3] = c.w; }
        } else {
            const u32x4_t* zk = (const u32x4_t*)(z + (size_t)row * DIN + ZO_K + kh * HD + 32 * hf); const u32x4_t* zv = (const u32x4_t*)(z + (size_t)row * DIN + ZO_V + kh * HD + 32 * hf);
#pragma unroll
            for (int i = 0; i < 4; ++i) { const u32x4_t a = zk[i], c = zv[i];
                kv[8 * i] = bf_lo(a.x); kv[8 * i + 1] = bf_hi(a.x); kv[8 * i + 2] = bf_lo(a.y); kv[8 * i + 3] = bf_hi(a.y); kv[8 * i + 4] = bf_lo(a.z); kv[8 * i + 5] = bf_hi(a.z); kv[8 * i + 6] = bf_lo(a.w); kv[8 * i + 7] = bf_hi(a.w);
                vv[8 * i] = bf_lo(c.x); vv[8 * i + 1] = bf_hi(c.x); vv[8 * i + 2] = bf_lo(c.y); vv[8 * i + 3] = bf_hi(c.y); vv[8 * i + 4] = bf_lo(c.z); vv[8 * i + 5] = bf_hi(c.z); vv[8 * i + 6] = bf_lo(c.w); vv[8 * i + 7] = bf_hi(c.w); }
        }
        float ssq = 0.f;
#pragma unroll
        for (int i = 0; i < 32; ++i) ssq += kv[i] * kv[i];
        ssq += __shfl_xor(ssq, 1);
        if (valid && need_norm) {
            const float rinv = __builtin_amdgcn_rsqf(ssq * (1.0f / HD) + EPSN);
#pragma unroll
            for (int i = 0; i < 8; ++i) { const f32x4_t gg = *(const f32x4_t*)(kg + 32 * hf + 4 * i);
                kv[4 * i] *= rinv * gg.x; kv[4 * i + 1] *= rinv * gg.y; kv[4 * i + 2] *= rinv * gg.z; kv[4 * i + 3] *= rinv * gg.w; }
        }
        if (wr_out) { float* ko = out + ((kind == 0) ? OUT_KP : OUT_KS) + oo; float* vo = out + ((kind == 0) ? OUT_VP : OUT_VS) + oo;
#pragma unroll
            for (int i = 0; i < 8; ++i) { ((f32x4_t*)ko)[i] = (f32x4_t){kv[4 * i], kv[4 * i + 1], kv[4 * i + 2], kv[4 * i + 3]}; ((f32x4_t*)vo)[i] = (f32x4_t){vv[4 * i], vv[4 * i + 1], vv[4 * i + 2], vv[4 * i + 3]}; } }
        LAS u32x4_t* kd = (LAS u32x4_t*)(lds + LDS_KS + s * (KS_PITCH * 2) + hf * 64);
#pragma unroll
        for (int i = 0; i < 4; ++i) { u32x4_t o; o.x = pk2(kv[8 * i], kv[8 * i + 1]); o.y = pk2(kv[8 * i + 2], kv[8 * i + 3]); o.z = pk2(kv[8 * i + 4], kv[8 * i + 5]); o.w = pk2(kv[8 * i + 6], kv[8 * i + 7]); kd[i] = o; }
        LAS bf16_t* vt = (LAS bf16_t*)(lds + LDS_VT);
#pragma unroll
        for (int i = 0; i < 32; i += 2) { const unsigned p = pk2(vv[i], vv[i + 1]); vt[(32 * hf + i) * VT_PITCH + s] = (bf16_t)(p & 0xffffu); vt[(32 * hf + i + 1) * VT_PITCH + s] = (bf16_t)(p >> 16); }
    }
    __syncthreads();
    asm volatile("" : "+v"(iq));
    if (active) {
        const int kb0 = (kind == 0) ? w : 0;
#pragma unroll
        for (int p = 0; p < 4; ++p) if (kind == 0 || p == 0) {
            attn_head(qa[p], qc[p], kh * 4 + (kind == 0 ? p : gl), iq, qrow, kb0, smin, smax, r, quad, qg, sinks, attn, lds);
            __builtin_amdgcn_sched_barrier(0);
        }
    }
    __syncthreads();
}

__device__ __forceinline__ void load_u8(const bf16_t* z, int row, int c, float (&u)[8]) {
    const u32x4_t xc = *(const u32x4_t*)(z + (size_t)row * DIN + ZO_XC + c), cg_ = *(const u32x4_t*)(z + (size_t)row * DIN + ZO_CG + c);
    u[0] = bf_lo(xc.x) * bf_lo(cg_.x); u[1] = bf_hi(xc.x) * bf_hi(cg_.x); u[2] = bf_lo(xc.y) * bf_lo(cg_.y); u[3] = bf_hi(xc.y) * bf_hi(cg_.y);
    u[4] = bf_lo(xc.z) * bf_lo(cg_.z); u[5] = bf_hi(xc.z) * bf_hi(cg_.z); u[6] = bf_lo(xc.w) * bf_lo(cg_.w); u[7] = bf_hi(xc.w) * bf_hi(cg_.w);
}
__device__ __forceinline__ void load_f8(const float* p, float (&u)[8]) {
    const f32x4_t a = *(const f32x4_t*)p, b = *(const f32x4_t*)(p + 4);
    u[0] = a.x; u[1] = a.y; u[2] = a.z; u[3] = a.w; u[4] = b.x; u[5] = b.y; u[6] = b.z; u[7] = b.w;
}
__device__ __forceinline__ void conv_item(int ci, const bf16_t* z, const float* state, const float* cw, bf16_t* ya, float* out) {
    const int tid = threadIdx.x, c = (tid & 127) * 8, rsub = tid >> 7, rbase = 32 * ci + 8 * rsub;
    float w0[8], w1[8], w2[8];
    load_f8(cw + c, w0); load_f8(cw + DCONV + c, w1); load_f8(cw + 2 * DCONV + c, w2);
    u32x4_t xcw[10], cgw[10], bgw[8];
#pragma unroll
    for (int i = 0; i < 10; ++i) { const int row = rbase - 2 + i; const int rc = row < 0 ? 0 : row;
        xcw[i] = *(const u32x4_t*)(z + (size_t)rc * DIN + ZO_XC + c); cgw[i] = *(const u32x4_t*)(z + (size_t)rc * DIN + ZO_CG + c); }
#pragma unroll
    for (int i = 0; i < 8; ++i) bgw[i] = *(const u32x4_t*)(z + (size_t)(rbase + i) * DIN + ZO_BG + c);
    float u[10][8];
#pragma unroll
    for (int i = 0; i < 10; ++i) {
        const u32x4_t xc = xcw[i], cg_ = cgw[i];
        u[i][0] = bf_lo(xc.x) * bf_lo(cg_.x); u[i][1] = bf_hi(xc.x) * bf_hi(cg_.x); u[i][2] = bf_lo(xc.y) * bf_lo(cg_.y); u[i][3] = bf_hi(xc.y) * bf_hi(cg_.y);
        u[i][4] = bf_lo(xc.z) * bf_lo(cg_.z); u[i][5] = bf_hi(xc.z) * bf_hi(cg_.z); u[i][6] = bf_lo(xc.w) * bf_lo(cg_.w); u[i][7] = bf_hi(xc.w) * bf_hi(cg_.w);
    }
#pragma unroll
    for (int i = 0; i < 8; ++i) {
        const int row = rbase + i;
        int t, sq; const bool samp = row >= MP;
        if (!samp) { sq = row / LP; t = row - sq * LP; } else { sq = (row - MP) / DECT; t = (row - MP) - sq * DECT; }
        float u1[8], u2[8];
        if (t >= 1) {
#pragma unroll
            for (int e = 0; e < 8; ++e) u1[e] = u[i + 1][e];
        } else if (samp) load_f8(state + ((size_t)sq * 2 + 1) * DCONV + c, u1);
        else {
#pragma unroll
            for (int e = 0; e < 8; ++e) u1[e] = 0.f;
        }
        if (t >= 2) {
#pragma unroll
            for (int e = 0; e < 8; ++e) u2[e] = u[i][e];
        } else if (samp) load_f8(state + ((size_t)sq * 2 + t) * DCONV + c, u2);
        else {
#pragma unroll
            for (int e = 0; e < 8; ++e) u2[e] = 0.f;
        }
        const u32x4_t bw = bgw[i];
        const float bg[8] = {bf_lo(bw.x), bf_hi(bw.x), bf_lo(bw.y), bf_hi(bw.y), bf_lo(bw.z), bf_hi(bw.z), bf_lo(bw.w), bf_hi(bw.w)};
        float y[8];
#pragma unroll
        for (int e = 0; e < 8; ++e) y[e] = bg[e] * (w0[e] * u2[e] + w1[e] * u1[e] + w2[e] * u[i + 2][e]);
        u32x4_t o; o.x = pk2(y[0], y[1]); o.y = pk2(y[2], y[3]); o.z = pk2(y[4], y[5]); o.w = pk2(y[6], y[7]);
        *(u32x4_t*)(ya + (size_t)row * DCONV + c) = o;
        float* no = nullptr;
        if (!samp) { if (t >= LP - 2) no = out + OUT_CP + ((size_t)sq * 2 + (t - (LP - 2))) * DCONV + c; }
        else { if (t >= DECT - 2) no = out + OUT_CS + ((size_t)sq * 2 + (t - (DECT - 2))) * DCONV + c; }
        if (no) { *(f32x4_t*)no = (f32x4_t){u[i + 2][0], u[i + 2][1], u[i + 2][2], u[i + 2][3]}; *(f32x4_t*)(no + 4) = (f32x4_t){u[i + 2][4], u[i + 2][5], u[i + 2][6], u[i + 2][7]}; }
    }
}

template <int MODE> __device__ __forceinline__ void fix_resid(const float* part, int nsl, const float* xp, const float* xs, const float* meta, float* xbuf, bf16_t* xb, float* ss, float* out, int gw, int ngw, int lane) {
    for (int it = gw; it < NTAIL * 8; it += ngw) {
        const int rloc = it >> 3, row = TAIL0 + rloc, col = (it & 7) * 256 + lane * 4;
        const bf16_t* p = (const bf16_t*)part + (size_t)rloc * 2048 + col;
        f32x4_t v = (f32x4_t){0.f, 0.f, 0.f, 0.f};
#pragma unroll 8
        for (int s = 0; s < nsl; ++s) { const u32x2_t w = __builtin_nontemporal_load((const u32x2_t*)(p + (size_t)s * (256 * 2048))); v += (f32x4_t){bf_lo(w.x), bf_hi(w.x), bf_lo(w.y), bf_hi(w.y)}; }
        const float scale = (MODE == 1) ? 1.0f : 0.5f;
        const float* base = (MODE == 0) ? x0_row(xp, xs, meta, row) : xbuf + (size_t)row * DM;
        const f32x4_t o = *(const f32x4_t*)(base + col) + v * scale;
        if (MODE == 2) { float* dst = y_row(out, row); if (dst) __builtin_nontemporal_store(o, (f32x4_t*)(dst + col)); }
        else {
            *(f32x4_t*)(xbuf + (size_t)row * DM + col) = o;
            u32x2_t w; w.x = pk2(o.x, o.y); w.y = pk2(o.z, o.w); *(u32x2_t*)(xb + (size_t)row * DM + col) = w;
            const float sq = wave_sum((o.x * o.x + o.y * o.y) + (o.z * o.z + o.w * o.w));
            if (lane == 0) __hip_atomic_fetch_add(ss + row, sq, __ATOMIC_RELAXED, __HIP_MEMORY_SCOPE_AGENT);
        }
    }
}
__device__ __forceinline__ void fix_gate(const float* part, int nsl, const bf16_t* z, bf16_t* mixed, int gw, int ngw, int lane) {
    for (int it = gw; it < NTAIL * 8; it += ngw) {
        const int rloc = it >> 3, row = TAIL0 + rloc, col = (it & 7) * 256 + lane * 4;
        const bf16_t* p = (const bf16_t*)part + (size_t)rloc * 2048 + col;
        f32x4_t a = (f32x4_t){0.f, 0.f, 0.f, 0.f}, b = (f32x4_t){0.f, 0.f, 0.f, 0.f};
#pragma unroll 8
        for (int s = 0; s < nsl; ++s) { const u32x2_t wa = __builtin_nontemporal_load((const u32x2_t*)(p + (size_t)s * (256 * 2048))), wb = __builtin_nontemporal_load((const u32x2_t*)(p + (size_t)(s + nsl) * (256 * 2048)));
            a += (f32x4_t){bf_lo(wa.x), bf_hi(wa.x), bf_lo(wa.y), bf_hi(wa.y)}; b += (f32x4_t){bf_lo(wb.x), bf_hi(wb.x), bf_lo(wb.y), bf_hi(wb.y)}; }
        const u32x2_t gc = *(const u32x2_t*)(z + (size_t)row * DIN + ZO_GC + col), ga = *(const u32x2_t*)(z + (size_t)row * DIN + ZO_GA + col);
        u32x2_t w;
        w.x = pk2(bf_lo(gc.x) * a.x + bf_lo(ga.x) * b.x, bf_hi(gc.x) * a.y + bf_hi(ga.x) * b.y);
        w.y = pk2(bf_lo(gc.y) * a.z + bf_lo(ga.y) * b.z, bf_hi(gc.y) * a.w + bf_hi(ga.y) * b.w);
        *(u32x2_t*)(mixed + (size_t)row * DM + col) = w;
    }
}

constexpr int I_UP = (DM / 64) * (2 * DFF / 64), I_DN = (DFF / 64) * (DM / 64), I_IN = (DM / 64) * (DIN / 64), I_C = (DCONV / 64) * (DM / 64), I_O = (DM / 64) * (DM / 64);
constexpr int CI_DN1 = I_UP, CI_IN = CI_DN1 + I_DN, CI_C = CI_IN + I_IN, CI_A = CI_C + I_C, CI_O = CI_A + I_C, CI_UP2 = CI_O + I_O, CI_DN2 = CI_UP2 + I_UP, CI_END = CI_DN2 + I_DN;
struct CvtItem { const float* src; const float* gp; bf16_t* dst; int N, K; };
__device__ __forceinline__ void cvt_decode(int it, int lane, const Args& args, CvtItem& d) {
    const float* W; const float* gain = nullptr; int K, N, mode = 0, item, blk = 0; size_t wo;
    if (it < CI_DN1)      { W = args.in[7];  K = DM;    N = 2 * DFF; wo = WS_WUP1; gain = args.in[6];  mode = 1; item = it; blk = 1; }
    else if (it < CI_IN)  { W = args.in[8];  K = DFF;   N = DM;      wo = WS_WDN1; item = it - CI_DN1; blk = 1; }
    else if (it < CI_C)   { W = args.in[10]; K = DM;    N = DIN;     wo = WS_WIN;  gain = args.in[9];  item = it - CI_IN; blk = 1; }
    else if (it < CI_A)   { W = args.in[14]; K = DCONV; N = DM;      wo = WS_WC;   item = it - CI_C; }
    else if (it < CI_O)   { W = args.in[16]; K = QDIM;  N = DM;      wo = WS_WA;   item = it - CI_A; }
    else if (it < CI_UP2) { W = args.in[17]; K = DM;    N = DM;      wo = WS_WO;   item = it - CI_O; }
    else if (it < CI_DN2) { W = args.in[19]; K = DM;    N = 2 * DFF; wo = WS_WUP2; gain = args.in[18]; mode = 1; item = it - CI_UP2; blk = 1; }
    else                  { W = args.in[20]; K = DFF;   N = DM;      wo = WS_WDN2; item = it - CI_DN2; blk = 1; }
    const int nblk = N / 64, kb = item / nblk, nb = item - kb * nblk, k0 = 64 * kb, n0 = 64 * nb;
    int nd0 = n0;
    if (mode == 1) { if (n0 < DFF) nd0 = 256 * (n0 / 128) + (n0 % 128); else { const int j = n0 - DFF; nd0 = 256 * (j / 128) + 128 + (j % 128); } }
    d.src = W + (size_t)(k0 + (lane >> 4)) * N + n0 + (lane & 15) * 4;
    d.gp = gain ? gain + k0 + (lane >> 4) : nullptr;
    const int nrow = nd0 + (lane >> 3);
    if (blk) { d.dst = (bf16_t*)(args.ws + wo) + (((size_t)(nrow >> 8) * (K / 64) + kb) * 256 + (nrow & 255)) * 64 + 8 * (lane & 7); d.K = 64; }
    else { d.dst = (bf16_t*)(args.ws + wo) + (size_t)nrow * K + k0 + 8 * (lane & 7); d.K = K; }
    d.N = N;
}
__device__ __forceinline__ void cvt_load(const CvtItem& d, f32x4_t (&v)[16], float (&g)[16]) {
#pragma unroll
    for (int i = 0; i < 16; ++i) { v[i] = __builtin_nontemporal_load((const f32x4_t*)(d.src + (size_t)(4 * i) * d.N)); g[i] = d.gp ? d.gp[4 * i] : 1.0f; }
}
__device__ __forceinline__ void convert_range(int lo_it, int hi_it, int gw, int ngw, LAS unsigned char* lds, int wave, int lane_in, const Args& args) {
    int lane = lane_in; asm volatile("" : "+v"(lane));
    LAS float* scr = (LAS float*)(lds + wave * 16640);
    int it = lo_it + gw;
    if (it >= hi_it) return;
    CvtItem cur; f32x4_t v[16]; float g[16];
    cvt_decode(it, lane, args, cur); cvt_load(cur, v, g);
#pragma unroll 1
    for (;;) {
        const int itn = it + ngw; const bool more = itn < hi_it;
        CvtItem nxt = cur; f32x4_t vn[16]; float gn[16];
        if (more) { cvt_decode(itn, lane, args, nxt); cvt_load(nxt, vn, gn); }
        LAS float* d = scr + (lane >> 4) * 65 + (lane & 15) * 4;
#pragma unroll
        for (int i = 0; i < 16; ++i) { const f32x4_t x = v[i] * g[i]; LAS float* dd = d + (4 * i) * 65; dd[0] = x.x; dd[1] = x.y; dd[2] = x.z; dd[3] = x.w; }
        asm volatile("s_waitcnt lgkmcnt(0)" ::: "memory");
        const LAS float* s = scr + (8 * (lane & 7)) * 65 + (lane >> 3);
#pragma unroll
        for (int j = 0; j < 8; ++j) { const LAS float* sj = s + 8 * j;
            u32x4_t o; o.x = pk2(sj[0 * 65], sj[1 * 65]); o.y = pk2(sj[2 * 65], sj[3 * 65]); o.z = pk2(sj[4 * 65], sj[5 * 65]); o.w = pk2(sj[6 * 65], sj[7 * 65]);
            *(u32x4_t*)(cur.dst + (size_t)(8 * j) * cur.K) = o; }
        asm volatile("s_waitcnt lgkmcnt(0)" ::: "memory");
        if (!more) break;
        it = itn; cur = nxt;
#pragma unroll
        for (int i = 0; i < 16; ++i) { v[i] = vn[i]; g[i] = gn[i]; }
    }
}

__global__ void __launch_bounds__(NWAVES * 64, 2) fwd_megakernel(Args args) {
    extern __shared__ __attribute__((aligned(16))) unsigned char lds_raw[];
    LAS unsigned char* lds = (LAS unsigned char*)lds_raw;
    const int tid = threadIdx.x, lane = tid & 63, wave = __builtin_amdgcn_readfirstlane(tid >> 6);
    const int G = gridDim.x, bx = blockIdx.x;
    unsigned char* ws = args.ws;
    const float* x_prompt = args.in[0]; const float* x_sample = args.in[1]; const float* state_conv = args.in[2]; const float* cache_k = args.in[3]; const float* cache_v = args.in[4];
    const float* meta = args.in[5]; const float* g_ffn1 = args.in[6]; const float* w_up1 = args.in[7]; const float* w_dn1 = args.in[8]; const float* g_mix = args.in[9];
    const float* w_in = args.in[10]; const float* q_g = args.in[11]; const float* k_g = args.in[12]; const float* conv_w = args.in[13]; const float* w_conv_out = args.in[14];
    const float* sinks = args.in[15]; const float* w_attn_out = args.in[16]; const float* w_o = args.in[17]; const float* g_ffn2 = args.in[18]; const float* w_up2 = args.in[19]; const float* w_dn2 = args.in[20];
    float* out = args.out;
    float* ss0 = (float*)(ws + WS_SS); float* ss1 = ss0 + MPAD; float* ss2 = ss1 + MPAD;
    bf16_t* Wup1 = (bf16_t*)(ws + WS_WUP1); bf16_t* Wdn1 = (bf16_t*)(ws + WS_WDN1); bf16_t* Win = (bf16_t*)(ws + WS_WIN); bf16_t* Wc = (bf16_t*)(ws + WS_WC); bf16_t* Wa = (bf16_t*)(ws + WS_WA);
    bf16_t* Wo = (bf16_t*)(ws + WS_WO); bf16_t* Wup2 = (bf16_t*)(ws + WS_WUP2); bf16_t* Wdn2 = (bf16_t*)(ws + WS_WDN2);
    bf16_t* xb = (bf16_t*)(ws + WS_XB); bf16_t* ya = (bf16_t*)(ws + WS_YA); bf16_t* at = (bf16_t*)(ws + WS_AT); bf16_t* zb = (bf16_t*)(ws + WS_Z); bf16_t* act = (bf16_t*)(ws + WS_ACT);
    float* x1 = (float*)(ws + WS_X1); bf16_t* mixed = (bf16_t*)(ws + WS_MIX);
    const int lo = args.ph_lo, hi = args.ph_hi;
    const int GG_UP = (G >= 64) ? G - 16 : G / 2, GG_IN = (G >= 64) ? G - 24 : G / 2;
    if (hi > 1000) cg::this_grid().sync();
    if (tid < 2) ((volatile LAS unsigned*)(lds + LDS_MISC_OFF))[tid] = 0u;
    __syncthreads();
    XcdBarrier bar = xcd_barrier_post((unsigned*)(ws + WS_BAR), (volatile LAS unsigned*)(lds + LDS_MISC_OFF));
#ifndef PH_MASK
#define PH_MASK 0x1fff
#endif
#define IN(k) (((PH_MASK >> (k)) & 1) && lo <= (k) && (k) < hi)
#define SEAM(k) do { if (IN(k) && IN((k) + 1)) { if (FLAT_BARRIER) flat_barrier((unsigned*)(ws + WS_BAR) + 64); else xcd_barrier(bar); } } while (0)

    for (int rep_ = 0; rep_ < ((PROBE_DUP == 1) ? 2 : 1); ++rep_)
    if (IN(0)) {
        const int gw = bx * NWAVES + wave, NGW = G * NWAVES;
        convert_range(0, CI_DN1, gw, NGW, lds, wave, lane, args);
        for (int m = gw; m < MPAD; m += 2 * NGW) {
            const int m2 = m + NGW; const bool has2 = m2 < MPAD, za = m >= MV, zb_ = (!has2) || m2 >= MV;
            const f32x4_t* xa = (const f32x4_t*)x0_row(x_prompt, x_sample, meta, m) + lane;
            const f32x4_t* xc = (const f32x4_t*)x0_row(x_prompt, x_sample, meta, has2 ? m2 : m) + lane;
            f32x4_t va[8], vb[8];
#pragma unroll
            for (int j = 0; j < 8; ++j) { va[j] = za ? (f32x4_t){0.f, 0.f, 0.f, 0.f} : xa[64 * j]; vb[j] = zb_ ? (f32x4_t){0.f, 0.f, 0.f, 0.f} : xc[64 * j]; }
            float sa = 0.f, sb = 0.f;
            unsigned long long* oa = (unsigned long long*)(xb + (size_t)m * DM) + lane; unsigned long long* ob = (unsigned long long*)(xb + (size_t)(has2 ? m2 : m) * DM) + lane;
#pragma unroll
            for (int j = 0; j < 8; ++j) {
                sa += (va[j].x * va[j].x + va[j].y * va[j].y) + (va[j].z * va[j].z + va[j].w * va[j].w);
                sb += (vb[j].x * vb[j].x + vb[j].y * vb[j].y) + (vb[j].z * vb[j].z + vb[j].w * vb[j].w);
                oa[64 * j] = (unsigned long long)pk2(va[j].x, va[j].y) | ((unsigned long long)pk2(va[j].z, va[j].w) << 32);
                if (has2) ob[64 * j] = (unsigned long long)pk2(vb[j].x, vb[j].y) | ((unsigned long long)pk2(vb[j].z, vb[j].w) << 32);
            }
            sa = wave_sum(sa); sb = wave_sum(sb);
            if (lane == 0) { ss0[m] = sa; ss1[m] = 0.f; ss2[m] = 0.f; if (has2) { ss0[m2] = sb; ss1[m2] = 0.f; ss2[m2] = 0.f; } }
        }
    }
    SEAM(0);
    if (PROBE_DUP == 3) { for (int rep_ = 0; rep_ < 16; ++rep_) SEAM(0); }
    const int gw = bx * NWAVES + wave, NGW = G * NWAVES;
    float* part_o = out;
    float* part_w = (float*)(ws + WS_WDN1);
    for (int rep_ = 0; rep_ < ((PROBE_DUP == 4) ? 2 : 1); ++rep_)
    if (IN(1)) {
        if (bx < GG_UP) { pg8::Gemm g{xb, Wup1, MPAD, 2 * DFF, DM, nullptr, 0, 1}; pg8::StaticOrder S; S.init(MPAD, 2 * DFF, DM, GG_UP, bx);
            pg8::EpiSwiglu E{act, ss0};
            pg8::gemm_phase<pg8::EpiSwiglu, pg8::StaticOrder, true, true>(lds, g, S, E); }
        else convert_range(CI_DN1, CI_C, (bx - GG_UP) * NWAVES + wave, (G - GG_UP) * NWAVES, lds, wave, lane, args);
    }
    SEAM(1);
    if (IN(2)) {
        pg8::Gemm g{act, Wdn1, MPAD, DM, DFF, part_o, 1, 1}; pg8::TailOrder S; S.init(DFF, 32, 0, G, bx);
        pg8::EpiResid<0> E{x_prompt, x_sample, meta, x1, xb, ss1, out};
        pg8::gemm_phase<pg8::EpiResid<0>, pg8::TailOrder, true, true>(lds, g, S, E);
    }
    SEAM(2);
    if (IN(3)) fix_resid<0>(part_o, 32, x_prompt, x_sample, meta, x1, xb, ss1, out, gw, NGW, lane);
    SEAM(3);
    for (int rep_ = 0; rep_ < ((PROBE_DUP == 5) ? 2 : 1); ++rep_)
    if (IN(4)) {
        if (bx < GG_IN) { pg8::Gemm g{xb, Win, MPAD, DIN, DM, nullptr, 0, 1}; pg8::StaticOrder S; S.init(MPAD, DIN, DM, GG_IN, bx);
            pg8::EpiZ E{zb, ss1};
            pg8::gemm_phase<pg8::EpiZ, pg8::StaticOrder, true, true>(lds, g, S, E); }
        else convert_range(CI_C, CI_DN2, (bx - GG_IN) * NWAVES + wave, (G - GG_IN) * NWAVES, lds, wave, lane, args);
    }
    SEAM(4);
    for (int rep_ = 0; rep_ < ((PROBE_DUP == 2) ? 2 : 1); ++rep_)
    if (IN(5)) {
        constexpr int N_PH = NB * NKV * 16, N_PL = NB * NKV, N_SA = DECB * NKV, N_CV = MV / 32, N_IT = N_PH + N_PL + N_SA + N_CV;
        for (int it = bx; it < N_IT; it += G) {
            if (it < N_PH + N_PL) { const int bk = (it < N_PH) ? (it >> 4) : (it - N_PH), j = (it < N_PH) ? 1 + (it & 15) : 0; attn_unit(0, bk >> 2, bk & 3, j, zb, cache_k, cache_v, q_g, k_g, sinks, at, out, lds); }
            else if (it < N_PH + N_PL + N_SA) { const int u = it - N_PH - N_PL; attn_unit(1, u >> 2, u & 3, 0, zb, cache_k, cache_v, q_g, k_g, sinks, at, out, lds); }
            else conv_item(it - N_PH - N_PL - N_SA, zb, state_conv, conv_w, ya, out);
        }
    }
    SEAM(5);
    if (IN(6)) {
#pragma unroll 1
        for (int pass = 0; pass < 2; ++pass) {
            pg8::Gemm g{pass ? at : ya, pass ? Wa : Wc, MPAD, DM, DCONV, (float*)((bf16_t*)part_o + (size_t)pass * 8 * 256 * 2048), 0, 0}; pg8::TailOrder S; S.init(DCONV, 8, pass * 64, G, bx);
            pg8::EpiGate E{mixed, zb, pass};
            pg8::gemm_phase<pg8::EpiGate, pg8::TailOrder, true, true>(lds, g, S, E);
        }
    }
    SEAM(6);
    if (IN(7)) fix_gate(part_o, 8, zb, mixed, gw, NGW, lane);
    SEAM(7);
    if (IN(8)) {
        pg8::Gemm g{mixed, Wo, MPAD, DM, DM, part_o, 0, 0}; pg8::TailOrder S; S.init(DM, 16, 0, G, bx);
        pg8::EpiResid<1> E{x_prompt, x_sample, meta, x1, xb, ss2, out};
        pg8::gemm_phase<pg8::EpiResid<1>, pg8::TailOrder, true, true>(lds, g, S, E);
    }
    SEAM(8);
    if (IN(9)) fix_resid<1>(part_o, 16, x_prompt, x_sample, meta, x1, xb, ss2, out, gw, NGW, lane);
    SEAM(9);
    if (IN(10)) {
        if (bx < GG_UP) { pg8::Gemm g{xb, Wup2, MPAD, 2 * DFF, DM, nullptr, 0, 1}; pg8::StaticOrder S; S.init(MPAD, 2 * DFF, DM, GG_UP, bx);
            pg8::EpiSwiglu E{act, ss2};
            pg8::gemm_phase<pg8::EpiSwiglu, pg8::StaticOrder, true, true>(lds, g, S, E); }
        else convert_range(CI_DN2, CI_END, (bx - GG_UP) * NWAVES + wave, (G - GG_UP) * NWAVES, lds, wave, lane, args);
    }
    SEAM(10);
    for (int rep_ = 0; rep_ < ((PROBE_DUP == 6) ? 2 : 1); ++rep_) {
    if (rep_ == 1) { if (FLAT_BARRIER) flat_barrier((unsigned*)(ws + WS_BAR) + 64); else xcd_barrier(bar); }
    if (IN(11)) {
        pg8::Gemm g{act, Wdn2, MPAD, DM, DFF, part_w, 1, 1}; pg8::TailOrder S; S.init(DFF, 32, 0, G, bx);
        pg8::EpiResid<2> E{x_prompt, x_sample, meta, x1, xb, ss2, out};
        pg8::gemm_phase<pg8::EpiResid<2>, pg8::TailOrder, true, true>(lds, g, S, E);
    }
    SEAM(11);
    if (IN(12)) fix_resid<2>(part_w, 32, x_prompt, x_sample, meta, x1, xb, ss2, out, gw, NGW, lane);
    }
#undef IN
#undef SEAM
}

extern "C" void kernel_launch(void* const* d_in, const int* in_sizes, int n_in, void* d_out, int out_size, void* d_ws, size_t ws_size, hipStream_t stream) {
    static int grid = 0;
    if (grid == 0) {
        if (n_in != 21 || out_size != (int)OUT_END || ws_size < WS_END) { fprintf(stderr, "kernel_launch: unexpected shapes: n_in %d out %d ws %zu (need %zu)\n", n_in, out_size, ws_size, (size_t)WS_END); grid = -1; return; }
        int dev = 0, cus = 0, per_cu = 0;
        if (hipGetDevice(&dev) != hipSuccess || hipDeviceGetAttribute(&cus, hipDeviceAttributeMultiprocessorCount, dev) != hipSuccess) { grid = -1; return; }
        if (hipFuncSetAttribute((const void*)fwd_megakernel, hipFuncAttributeMaxDynamicSharedMemorySize, LDS_BYTES) != hipSuccess) { fprintf(stderr, "kernel_launch: hipFuncSetAttribute failed\n"); grid = -1; return; }
        if (hipOccupancyMaxActiveBlocksPerMultiprocessor(&per_cu, (const void*)fwd_megakernel, NWAVES * 64, LDS_BYTES) != hipSuccess || per_cu < 1) { fprintf(stderr, "kernel_launch: occupancy query says %d\n", per_cu); per_cu = 1; }
        (void)hipGetLastError();
        grid = cus;
    }
    if (grid < 0) return;
    if (hipMemsetAsync((char*)d_ws + WS_BAR, 0, BAR_ZERO_BYTES, stream) != hipSuccess) { fprintf(stderr, "kernel_launch: memset failed\n"); return; }
    Args a{};
    for (int i = 0; i < 21; ++i) a.in[i] = (const float*)d_in[i];
    a.out = (float*)d_out; a.ws = (unsigned char*)d_ws;
    if (MK_N_LAUNCHES == 1) {
        a.ph_lo = 0; a.ph_hi = N_PHASES;
        void* kargs[] = {&a};
        const hipError_t e = hipLaunchCooperativeKernel((const void*)fwd_megakernel, dim3(grid), dim3(NWAVES * 64), kargs, LDS_BYTES, stream);
        if (e != hipSuccess) fprintf(stderr, "kernel_launch: cooperative launch failed: %s (grid %d)\n", hipGetErrorString(e), grid);
    } else {
        for (int p = 0; p < N_PHASES; ++p) { a.ph_lo = p; a.ph_hi = p + 1; hipLaunchKernelGGL(fwd_megakernel, dim3(grid), dim3(NWAVES * 64), LDS_BYTES, stream, a); }
    }
}
```

```cpp
#include <hip/hip_runtime.h>
#include <hip/hip_cooperative_groups.h>
#include <cstdio>
#include <cstdint>
namespace cg = cooperative_groups;

constexpr int DM = 2048, NB = 4, SEQ = 2048, NMETA = 16, LP = SEQ + NMETA, DECB = 32, DECT = 4;
constexpr int MP = NB * LP  , MS = DECB * DECT  , MV = MP + MS  , MPAD = 8448;
constexpr int DCONV = 1024, HD = 64, NH = 16, NKV = 4, QDIM = 1024, KVDIM = 256, DFF = 5504, DIN = 8704, NWIN = 128;
constexpr int ZO_XC = 0, ZO_BG = 1024, ZO_CG = 2048, ZO_Q = 3072, ZO_K = 4096, ZO_V = 4352, ZO_GC = 4608, ZO_GA = 6656;
constexpr float EPSN = 1e-6f;
constexpr size_t OUT_YP = 0, OUT_YS = 16777216, OUT_CP = 17039360, OUT_KP = 17047552, OUT_VP = 17178624, OUT_CS = 17309696, OUT_KS = 17375232, OUT_VS = 18423808, OUT_END = 19472384;

typedef unsigned short bf16_t;
#define LAS __attribute__((address_space(3)))
typedef unsigned u32x4_t __attribute__((ext_vector_type(4)));
typedef unsigned u32x2_t __attribute__((ext_vector_type(2)));
typedef float f32x4_t __attribute__((ext_vector_type(4)));

__device__ __forceinline__ const float* x0_row(const float* xp, const float* xs, const float* meta, int row) {
    if (row >= MV) row = MV - 1;
    if (row >= MP) return xs + (size_t)(row - MP) * DM;
    const int b = row / LP, t = row - b * LP;
    return t < NMETA ? meta + (size_t)t * DM : xp + ((size_t)b * SEQ + (t - NMETA)) * DM;
}
__device__ __forceinline__ float* y_row(float* out, int row) {
    if (row >= MV) return nullptr;
    if (row >= MP) return out + OUT_YS + (size_t)(row - MP) * DM;
    const int b = row / LP, t = row - b * LP;
    if (t < NMETA) return nullptr;
    return out + OUT_YP + ((size_t)b * SEQ + (t - NMETA)) * DM;
}
__device__ __forceinline__ float bf_lo(unsigned w) { return __uint_as_float(w << 16); }
__device__ __forceinline__ float bf_hi(unsigned w) { return __uint_as_float(w & 0xffff0000u); }

namespace pg8 {
#define PG8_LAS __attribute__((address_space(3)))
typedef unsigned short bf16_t;
typedef short bf16x8 __attribute__((ext_vector_type(8)));
typedef float f32x4 __attribute__((ext_vector_type(4)));
typedef unsigned u32x4 __attribute__((ext_vector_type(4)));
constexpr int BM = 256, BK = 64, HALF = 128, HTB = HALF * BK * 2  , STAGE_BYTES = 8 * HTB, NXCD = 8, WGM = 6;

__host__ __device__ __forceinline__ int lds_byte(int r, int c) { const int st = (r >> 4) * 2 + (c >> 5), rr = r & 15, cc = c & 31, ob = rr * 64 + cc * 2; return st * 1024 + (ob ^ (((ob >> 9) & 1) << 5)); }
__host__ __device__ __forceinline__ void stage_rc(int b, int& R, int& C) { const int st = b / 1024, sb = b % 1024, swz = sb ^ (((sb >> 9) & 1) << 5); R = (st >> 1) * 16 + swz / 64; C = (st & 1) * 32 + (swz % 64) / 2; }
__host__ __device__ __forceinline__ int perm32(int rho) { const int n = rho >> 4, i = rho & 15; return 8 * (i >> 2) + 4 * n + (i & 3); }

struct Unit { int pm, pn, k0, nk, part; };
struct Gemm { const bf16_t* A; const bf16_t* Bt; int M, N, K; float* part; int a_blk, b_blk; };

struct StaticOrder {
    int nM, nN, nwg, G, c, nkf;
    __host__ __device__ void init(int M, int N, int K, int G_, int c_) { nM = M / BM; nN = N / BM; nwg = nM * nN; G = G_; c = c_; nkf = K / BK; }
    __host__ __device__ bool next(int i, Unit& u) const {
        const long L = (long)i * G + c; const int xcd = (int)(L % NXCD), off = (int)(L / NXCD);
        const int b0 = xcd == 0 ? 0 : ((xcd * nwg / NXCD + WGM / 2) / WGM) * WGM, b1 = xcd == NXCD - 1 ? nwg : (((xcd + 1) * nwg / NXCD + WGM / 2) / WGM) * WGM;
        if (b0 + off >= b1) return false;
        const int wgid = b0 + off;
        const int nig = WGM * nN, gid = wgid / nig, fm = gid * WGM, gsz = (nM - fm) < WGM ? (nM - fm) : WGM;
        u.pm = fm + ((wgid % nig) % gsz); u.pn = (wgid % nig) / gsz; u.k0 = 0; u.nk = nkf; u.part = -1; return true;
    }
    __device__ __forceinline__ void a_ready(const Unit&) const {}
    __device__ __forceinline__ void done(const Unit&) const {}
};

struct TailOrder {
    int G, c, nkf, nsl, poff;
    __host__ __device__ void init(int K, int nsl_, int poff_, int G_, int c_) { G = G_; c = c_; nkf = K / BK; nsl = nsl_; poff = poff_; }
    __host__ __device__ bool next(int i, Unit& u) const {
        const long L = (long)i * G + c;
        if (L < 256) {
            const int xcd = (int)L % NXCD, off = (int)L / NXCD;
            u.pm = xcd * 4 + (off & 3); u.pn = off >> 2; u.k0 = 0; u.nk = nkf; u.part = -1; return true;
        }
        const long p = L - 256 - poff; if (p < 0 || p >= 8 * nsl) return false;
        const int sl = (int)p / 8, pairs = nkf / 2, base = pairs / nsl, rem = pairs % nsl;
        u.pm = 32; u.pn = (int)p % 8; u.k0 = 2 * (sl * base + (sl < rem ? sl : rem)); u.nk = 2 * (base + (sl < rem ? 1 : 0)); u.part = sl; return true;
    }
    __device__ __forceinline__ void a_ready(const Unit&) const {}
    __device__ __forceinline__ void done(const Unit&) const {}
};
__device__ __forceinline__ unsigned cvt_pk_bf16(float lo, float hi) { unsigned r; asm volatile("v_cvt_pk_bf16_f32 %0, %1, %2" : "=v"(r) : "v"(lo), "v"(hi)); return r; }
__device__ __forceinline__ float silu_mul(float g, float u) { return g * __builtin_amdgcn_rcpf(1.0f + __builtin_amdgcn_exp2f(-1.4426950408889634f * g)) * u; }
__device__ __forceinline__ float sigmoidf_(float v) { return __builtin_amdgcn_rcpf(1.0f + __builtin_amdgcn_exp2f(-1.4426950408889634f * v)); }

struct EpiSwiglu {
    static constexpr bool PERM = true, AFTER_DRAIN = false;
    bf16_t* act; const float* ss;
    __device__ __forceinline__ void operator()(const f32x4 (&acc)[2][2][4][2], const Unit& u, int wr, int wc, int fr, int fq) const {
        const int row0 = u.pm * BM + wr * 64 + fr, j0 = u.pn * HALF + wc * 32 + 8 * fq;
        float rs[2][4];
#pragma unroll
        for (int ai = 0; ai < 2; ++ai)
#pragma unroll
            for (int m = 0; m < 4; ++m) rs[ai][m] = ss[row0 + ai * HALF + m * 16];
        __builtin_amdgcn_sched_barrier(0);
#pragma unroll
        for (int ai = 0; ai < 2; ++ai)
#pragma unroll
            for (int m = 0; m < 4; ++m) {
                const int row = row0 + ai * HALF + m * 16;
                const float r = __builtin_amdgcn_rsqf(rs[ai][m] * (1.0f / DM) + EPSN);
                const f32x4 g0 = acc[ai][0][m][0] * r, g1 = acc[ai][0][m][1] * r, u0 = acc[ai][1][m][0] * r, u1 = acc[ai][1][m][1] * r;
                u32x4 w;
                w.x = cvt_pk_bf16(silu_mul(g0[0], u0[0]), silu_mul(g0[1], u0[1])); w.y = cvt_pk_bf16(silu_mul(g0[2], u0[2]), silu_mul(g0[3], u0[3]));
                w.z = cvt_pk_bf16(silu_mul(g1[0], u1[0]), silu_mul(g1[1], u1[1])); w.w = cvt_pk_bf16(silu_mul(g1[2], u1[2]), silu_mul(g1[3], u1[3]));
                *(u32x4*)(act + (((size_t)u.pm * (DFF / 64) + (u.pn * 2 + (wc >> 1))) * 256 + (row - u.pm * BM)) * 64 + (wc & 1) * 32 + 8 * fq) = w;
                __builtin_amdgcn_sched_barrier(0);
            }
    }
};

struct EpiZ {
    static constexpr bool PERM = true, AFTER_DRAIN = false;
    bf16_t* z; const float* ss;
    __device__ __forceinline__ void operator()(const f32x4 (&acc)[2][2][4][2], const Unit& u, int wr, int wc, int fr, int fq) const {
        const int row0 = u.pm * BM + wr * 64 + fr, col0 = u.pn * BM + wc * 32 + 8 * fq;
        const bool sig = (u.pn * BM >= ZO_GC);
        float rs[2][4];
#pragma unroll
        for (int ai = 0; ai < 2; ++ai)
#pragma unroll
            for (int m = 0; m < 4; ++m) rs[ai][m] = ss[row0 + ai * HALF + m * 16];
        __builtin_amdgcn_sched_barrier(0);
#pragma unroll
        for (int ai = 0; ai < 2; ++ai)
#pragma unroll
            for (int m = 0; m < 4; ++m) {
                const int row = row0 + ai * HALF + m * 16;
                const float r = __builtin_amdgcn_rsqf(rs[ai][m] * (1.0f / DM) + EPSN);
#pragma unroll
                for (int bj = 0; bj < 2; ++bj) {
                    f32x4 v0 = acc[ai][bj][m][0] * r, v1 = acc[ai][bj][m][1] * r;
                    if (sig) {
#pragma unroll
                        for (int i = 0; i < 4; ++i) { v0[i] = sigmoidf_(v0[i]); v1[i] = sigmoidf_(v1[i]); }
                    }
                    u32x4 w; w.x = cvt_pk_bf16(v0[0], v0[1]); w.y = cvt_pk_bf16(v0[2], v0[3]); w.z = cvt_pk_bf16(v1[0], v1[1]); w.w = cvt_pk_bf16(v1[2], v1[3]);
                    *(u32x4*)(z + (size_t)row * DIN + col0 + bj * HALF) = w;
                }
                __builtin_amdgcn_sched_barrier(0);
            }
    }
};

struct EpiGate {
    static constexpr bool PERM = true, AFTER_DRAIN = false;
    bf16_t* mixed; const bf16_t* z; int PASS;
    __device__ __forceinline__ void operator()(const f32x4 (&acc)[2][2][4][2], const Unit& u, int wr, int wc, int fr, int fq) const {
        const int row0 = u.pm * BM + wr * 64 + fr, col0 = u.pn * BM + wc * 32 + 8 * fq;
        const int zo = PASS ? ZO_GA : ZO_GC;
#pragma unroll
        for (int ai = 0; ai < 2; ++ai) {
            u32x4 gw[4][2], pw[4][2];
#pragma unroll
            for (int m = 0; m < 4; ++m)
#pragma unroll
                for (int bj = 0; bj < 2; ++bj) {
                    const int row = row0 + ai * HALF + m * 16, c = col0 + bj * HALF;
                    gw[m][bj] = *(const u32x4*)(z + (size_t)row * DIN + zo + c);
                    pw[m][bj] = PASS ? *(const u32x4*)(mixed + (size_t)row * DM + c) : (u32x4){0u, 0u, 0u, 0u};
                }
            __builtin_amdgcn_sched_barrier(0);
#pragma unroll
            for (int m = 0; m < 4; ++m) {
                const int row = row0 + ai * HALF + m * 16;
#pragma unroll
                for (int bj = 0; bj < 2; ++bj) {
                    const int c = col0 + bj * HALF;
                    const u32x4 g = gw[m][bj], p = pw[m][bj];
                    f32x4 v0 = acc[ai][bj][m][0], v1 = acc[ai][bj][m][1];
                    v0[0] = v0[0] * bf_lo(g.x) + bf_lo(p.x); v0[1] = v0[1] * bf_hi(g.x) + bf_hi(p.x); v0[2] = v0[2] * bf_lo(g.y) + bf_lo(p.y); v0[3] = v0[3] * bf_hi(g.y) + bf_hi(p.y);
                    v1[0] = v1[0] * bf_lo(g.z) + bf_lo(p.z); v1[1] = v1[1] * bf_hi(g.z) + bf_hi(p.z); v1[2] = v1[2] * bf_lo(g.w) + bf_lo(p.w); v1[3] = v1[3] * bf_hi(g.w) + bf_hi(p.w);
                    u32x4 w; w.x = cvt_pk_bf16(v0[0], v0[1]); w.y = cvt_pk_bf16(v0[2], v0[3]); w.z = cvt_pk_bf16(v1[0], v1[1]); w.w = cvt_pk_bf16(v1[2], v1[3]);
                    *(u32x4*)(mixed + (size_t)row * DM + c) = w;
                }
                __builtin_amdgcn_sched_barrier(0);
            }
        }
    }
};

template <int MODE> struct EpiResid {
    static constexpr bool PERM = false, AFTER_DRAIN = false;
    const float* xp; const float* xs; const float* meta; float* xbuf; bf16_t* xb; float* ss; float* out;
    __device__ __forceinline__ void operator()(const f32x4 (&acc)[2][2][4][2], const Unit& u, int wr, int wc, int fr, int fq) const {
        const int row0 = u.pm * BM + wr * 64 + fr, col0 = u.pn * BM + wc * 32 + 4 * fq;
        const float scale = (MODE == 1) ? 1.0f : 0.5f;
#pragma unroll
        for (int ai = 0; ai < 2; ++ai) {
            u32x2_t bw[4][2][2];
#pragma unroll
            for (int m = 0; m < 4; ++m) {
                const bf16_t* base = xb + (size_t)(row0 + ai * HALF + m * 16) * DM + col0;
#pragma unroll
                for (int bj = 0; bj < 2; ++bj)
#pragma unroll
                    for (int n = 0; n < 2; ++n) bw[m][bj][n] = *(const u32x2_t*)(base + bj * HALF + n * 16);
            }
            __builtin_amdgcn_sched_barrier(0);
#pragma unroll
            for (int m = 0; m < 4; ++m) {
                const int row = row0 + ai * HALF + m * 16;
                float* dst = (MODE == 2) ? y_row(out, row) : nullptr;
                float sq = 0.f;
#pragma unroll
                for (int bj = 0; bj < 2; ++bj)
#pragma unroll
                    for (int n = 0; n < 2; ++n) {
                        const int c = col0 + bj * HALF + n * 16;
                        const u32x2_t w0 = bw[m][bj][n];
                        const f32x4 o = (f32x4){bf_lo(w0.x), bf_hi(w0.x), bf_lo(w0.y), bf_hi(w0.y)} + acc[ai][bj][m][n] * scale;
                        if (MODE == 2) { if (dst) __builtin_nontemporal_store(o, (f32x4*)(dst + c)); }
                        else {
                            u32x2_t w; w.x = cvt_pk_bf16(o[0], o[1]); w.y = cvt_pk_bf16(o[2], o[3]);
                            *(u32x2_t*)(xb + (size_t)row * DM + c) = w;
                            sq += (o[0] * o[0] + o[1] * o[1]) + (o[2] * o[2] + o[3] * o[3]);
                        }
                    }
                if (MODE != 2) {
                    sq += __shfl_xor(sq, 16); sq += __shfl_xor(sq, 32);
                    if (fq == 0) __hip_atomic_fetch_add(ss + row, sq, __ATOMIC_RELAXED, __HIP_MEMORY_SCOPE_AGENT);
                }
                __builtin_amdgcn_sched_barrier(0);
            }
        }
    }
};

template <bool PERM> __device__ __forceinline__ void store_part(const f32x4 (&acc)[2][2][4][2], const Unit& u, float* part, int wr, int wc, int fr, int fq) {
    bf16_t* base = (bf16_t*)part + (size_t)u.part * (256 * 2048);
    int rl0 = wr * 64 + fr; const int col0 = u.pn * BM + wc * 32 + (PERM ? 8 * fq : 4 * fq);
    asm volatile("" : "+v"(rl0));
#pragma unroll
    for (int ai = 0; ai < 2; ++ai)
#pragma unroll
        for (int m = 0; m < 4; ++m) {
            bf16_t* rp = base + (size_t)(rl0 + ai * HALF + m * 16) * 2048 + col0;
#pragma unroll
            for (int bj = 0; bj < 2; ++bj)
#pragma unroll
                for (int n = 0; n < 2; ++n) { const f32x4 v = acc[ai][bj][m][n]; u32x2_t w; w.x = cvt_pk_bf16(v[0], v[1]); w.y = cvt_pk_bf16(v[2], v[3]);
                    *(u32x2_t*)(rp + bj * HALF + (PERM ? 4 * n : 16 * n)) = w; }
            __builtin_amdgcn_sched_barrier(0);
        }
}

template <class Epi, class Sched, bool ALIGN_EPI = false, bool SP2 = false>
__device__ __forceinline__ void gemm_phase(PG8_LAS unsigned char* lds, const Gemm g, const Sched& S, const Epi& E) {
    const int tid = threadIdx.x, wid = __builtin_amdgcn_readfirstlane(tid >> 6), lane = tid & 63, wr = wid >> 2, wc = wid & 3, fr = lane & 15, fq = lane >> 4;
    const int K = g.K;
    const int pitchA = g.a_blk ? BK : K, pitchB = g.b_blk ? BK : K;
    unsigned voffA[2], voffB[2];
#pragma unroll
    for (int i = 0; i < 2; ++i) { int R, C; stage_rc(tid * 16 + i * 8192, R, C); const int Rb = Epi::PERM ? ((R & ~31) + perm32(R & 31)) : R;
        voffA[i] = (unsigned)(R * pitchA + C) * 2u; voffB[i] = (unsigned)(Rb * pitchB + C) * 2u; }
    const size_t kstepA = g.a_blk ? (size_t)(BM * BK * 2) : (size_t)(BK * 2), kstepB = g.b_blk ? (size_t)(BM * BK * 2) : (size_t)(BK * 2);
    const size_t hstepA = (size_t)HALF * pitchA * 2, hstepB = (size_t)HALF * pitchB * 2;
    const size_t tstep = (size_t)BM * K * 2;
    const unsigned ldsw = (unsigned)wid * 1024u;
    const int aoff = lds_byte(wr * 64 + fr, fq * 8), boff = lds_byte(wc * 32 + fr, fq * 8);
#define PG8_SA(b, h) (((b) * 2 + (h)) * HTB)
#define PG8_SB(b, h) ((4 + (b) * 2 + (h)) * HTB)
#define PG8_STAGE(bufoff, gbase, voff) do { _Pragma("unroll") for (int _i = 0; _i < 2; ++_i) \
        __builtin_amdgcn_global_load_lds((const unsigned*)((const char*)(gbase) + (voff)[_i]), (PG8_LAS unsigned*)(lds + (bufoff) + ldsw + _i * 8192), 16, 0, 0); } while (0)
#define PG8_LDA(dst, b, h) do { _Pragma("unroll") for (int m = 0; m < 4; ++m) _Pragma("unroll") for (int k = 0; k < 2; ++k) dst[m][k] = *(const PG8_LAS bf16x8*)(lds + PG8_SA(b, h) + aoff + m * 2048 + k * 1024); } while (0)
#define PG8_LDB(dst, b, h) do { _Pragma("unroll") for (int n = 0; n < 2; ++n) _Pragma("unroll") for (int k = 0; k < 2; ++k) dst[n][k] = *(const PG8_LAS bf16x8*)(lds + PG8_SB(b, h) + boff + n * 2048 + k * 1024); } while (0)
#define PG8_MMA(ai, bj, At, Bt) do { __builtin_amdgcn_s_setprio(1); _Pragma("unroll") for (int m = 0; m < 4; ++m) _Pragma("unroll") for (int n = 0; n < 2; ++n) _Pragma("unroll") for (int k = 0; k < 2; ++k) \
        acc[ai][bj][m][n] = __builtin_amdgcn_mfma_f32_16x16x32_bf16(Bt[n][k], At[m][k], acc[ai][bj][m][n], 0, 0, 0); __builtin_amdgcn_s_setprio(0); } while (0)
#define PG8_WAIT_V(n) asm volatile("s_waitcnt vmcnt(" #n ")" ::: "memory")
#define PG8_WAIT_L(n) asm volatile("s_waitcnt lgkmcnt(" #n ")" ::: "memory")
#define PG8_BAR __builtin_amdgcn_s_barrier()
#define PG8_SCHED __builtin_amdgcn_sched_barrier(0)
    Unit cur, nxt; int ui = 0;
    if (!S.next(0, cur)) return;
    int nt = cur.nk;
    f32x4 acc[2][2][4][2];
#pragma unroll
    for (int a = 0; a < 2; ++a)
#pragma unroll
        for (int b = 0; b < 2; ++b)
#pragma unroll
            for (int m = 0; m < 4; ++m)
#pragma unroll
                for (int n = 0; n < 2; ++n) acc[a][b][m][n] = (f32x4){0.f, 0.f, 0.f, 0.f};
    bf16x8 At[4][2], B0[2][2], B1[2][2];
    const char* cA = (const char*)g.A + (size_t)cur.pm * tstep + (size_t)cur.k0 * kstepA; const char* cB = (const char*)g.Bt + (size_t)cur.pn * tstep + (size_t)cur.k0 * kstepB;
    S.a_ready(cur);
    if constexpr (SP2) {
        PG8_STAGE(PG8_SB(0, 0), cB, voffB); PG8_STAGE(PG8_SB(0, 1), cB + hstepB, voffB); PG8_STAGE(PG8_SA(0, 0), cA, voffA); PG8_STAGE(PG8_SA(0, 1), cA + hstepA, voffA);
        if (wr == 1) PG8_BAR;
        PG8_WAIT_V(2); PG8_BAR;
        PG8_STAGE(PG8_SB(1, 0), cB + kstepB, voffB); PG8_STAGE(PG8_SA(1, 0), cA + kstepA, voffA); PG8_STAGE(PG8_SB(1, 1), cB + hstepB + kstepB, voffB);
        PG8_WAIT_V(6); PG8_BAR;
    } else {
        PG8_STAGE(PG8_SB(0, 0), cB, voffB); PG8_STAGE(PG8_SA(0, 0), cA, voffA); PG8_STAGE(PG8_SB(0, 1), cB + hstepB, voffB); PG8_STAGE(PG8_SA(0, 1), cA + hstepA, voffA);
        if (wr == 1) PG8_BAR;
        PG8_WAIT_V(4); PG8_BAR;
        PG8_STAGE(PG8_SB(1, 0), cB + kstepB, voffB); PG8_STAGE(PG8_SA(1, 0), cA + kstepA, voffA); PG8_STAGE(PG8_SB(1, 1), cB + hstepB + kstepB, voffB);
        PG8_WAIT_V(6); PG8_BAR;
    }
    for (;;) {
        const bool has_next = S.next(ui + 1, nxt);
        const char* nA = has_next ? (const char*)g.A + (size_t)nxt.pm * tstep + (size_t)nxt.k0 * kstepA : cA; const char* nB = has_next ? (const char*)g.Bt + (size_t)nxt.pn * tstep + (size_t)nxt.k0 * kstepB : cB;
        for (int t = 0; t < nt; t += 2) {
            const bool last = (t == nt - 2);
            const char* a1 = cA + (size_t)(t + 1) * kstepA;
            const char* a2 = last ? nA : cA + (size_t)(t + 2) * kstepA; const char* b2 = last ? nB : cB + (size_t)(t + 2) * kstepB;
            const char* a3 = a2 + kstepA; const char* b3 = b2 + kstepB;
            if (last && has_next) S.a_ready(nxt);
            if constexpr (SP2) {
            PG8_LDB(B0, 0, 0); PG8_LDB(B1, 0, 1); PG8_SCHED; PG8_LDA(At, 0, 0); PG8_STAGE(PG8_SA(1, 1), a1 + hstepA, voffA);
            PG8_WAIT_V(8); PG8_WAIT_L(0); PG8_BAR; PG8_MMA(0, 0, At, B0); PG8_MMA(0, 1, At, B1); PG8_BAR; PG8_SCHED;
            PG8_LDA(At, 0, 1); PG8_STAGE(PG8_SB(0, 0), b2, voffB); PG8_STAGE(PG8_SB(0, 1), b2 + hstepB, voffB); PG8_STAGE(PG8_SA(0, 0), a2, voffA);
            PG8_WAIT_V(8); PG8_WAIT_L(0); PG8_BAR; PG8_MMA(1, 0, At, B0); PG8_MMA(1, 1, At, B1); PG8_BAR; PG8_SCHED;
            PG8_LDB(B0, 1, 0); PG8_LDB(B1, 1, 1); PG8_SCHED; PG8_LDA(At, 1, 0); PG8_STAGE(PG8_SA(0, 1), a2 + hstepA, voffA);
            PG8_WAIT_V(8); PG8_WAIT_L(0); PG8_BAR; PG8_MMA(0, 0, At, B0); PG8_MMA(0, 1, At, B1); PG8_BAR; PG8_SCHED;
            PG8_LDA(At, 1, 1); PG8_STAGE(PG8_SB(1, 0), b3, voffB); PG8_STAGE(PG8_SB(1, 1), b3 + hstepB, voffB); PG8_STAGE(PG8_SA(1, 0), a3, voffA);
            PG8_WAIT_V(8); PG8_WAIT_L(0); PG8_BAR; PG8_MMA(1, 0, At, B0); PG8_MMA(1, 1, At, B1); PG8_BAR; PG8_SCHED;
            } else {
            PG8_LDB(B0, 0, 0); PG8_SCHED; PG8_LDA(At, 0, 0); PG8_STAGE(PG8_SA(1, 1), a1 + hstepA, voffA);
            PG8_WAIT_L(8); PG8_BAR; PG8_WAIT_L(0); PG8_MMA(0, 0, At, B0); PG8_BAR; PG8_SCHED;
            PG8_LDB(B1, 0, 1); PG8_STAGE(PG8_SB(0, 0), b2, voffB);
            PG8_BAR; PG8_WAIT_L(0); PG8_MMA(0, 1, At, B1); PG8_BAR;
            PG8_LDA(At, 0, 1); PG8_STAGE(PG8_SA(0, 0), a2, voffA);
            PG8_BAR; PG8_WAIT_L(0); PG8_MMA(1, 0, At, B0); PG8_BAR; PG8_SCHED;
            PG8_STAGE(PG8_SB(0, 1), b2 + hstepB, voffB);
            PG8_WAIT_V(6); PG8_BAR; PG8_MMA(1, 1, At, B1); PG8_BAR;
            PG8_LDB(B0, 1, 0); PG8_SCHED; PG8_LDA(At, 1, 0); PG8_STAGE(PG8_SA(0, 1), a2 + hstepA, voffA);
            PG8_WAIT_L(8); PG8_BAR; PG8_WAIT_L(0); PG8_MMA(0, 0, At, B0); PG8_BAR; PG8_SCHED;
            PG8_LDB(B1, 1, 1); PG8_STAGE(PG8_SB(1, 0), b3, voffB);
            PG8_BAR; PG8_WAIT_L(0); PG8_MMA(0, 1, At, B1); PG8_BAR;
            PG8_LDA(At, 1, 1); PG8_STAGE(PG8_SA(1, 0), a3, voffA);
            PG8_BAR; PG8_WAIT_L(0); PG8_MMA(1, 0, At, B0); PG8_BAR; PG8_SCHED;
            PG8_STAGE(PG8_SB(1, 1), b3 + hstepB, voffB);
            PG8_WAIT_V(6); PG8_BAR; PG8_MMA(1, 1, At, B1); PG8_BAR;
            }
        }
        if constexpr (ALIGN_EPI) { if (wr == 0) PG8_BAR; }
        if constexpr (!Epi::AFTER_DRAIN) { if (cur.part < 0) E(acc, cur, wr, wc, fr, fq); else store_part<Epi::PERM>(acc, cur, g.part, wr, wc, fr, fq); S.done(cur); }
        if (!has_next) break;
#pragma unroll
        for (int a = 0; a < 2; ++a)
#pragma unroll
            for (int b = 0; b < 2; ++b)
#pragma unroll
                for (int m = 0; m < 4; ++m)
#pragma unroll
                    for (int n = 0; n < 2; ++n) acc[a][b][m][n] = (f32x4){0.f, 0.f, 0.f, 0.f};
        cur = nxt; cA = nA; cB = nB; ++ui; nt = cur.nk;
        if constexpr (ALIGN_EPI) { if (wr == 1) PG8_BAR; }
    }
    PG8_WAIT_V(0);
    if constexpr (!ALIGN_EPI) { if (wr == 0) PG8_BAR; }
    PG8_BAR;
    if constexpr (Epi::AFTER_DRAIN) { E.fused(acc, cur, wr, wc, fr, fq, lds, wid, lane); S.done(cur); }
#undef PG8_SA
#undef PG8_SB
#undef PG8_STAGE
#undef PG8_LDA
#undef PG8_LDB
#undef PG8_MMA
#undef PG8_WAIT_V
#undef PG8_WAIT_L
#undef PG8_BAR
#undef PG8_SCHED
}
}

constexpr int NWAVES = 8;
#ifndef PROBE_DUP
#define PROBE_DUP 0
#endif
#ifndef MK_N_LAUNCHES
#define MK_N_LAUNCHES 1
#endif
constexpr int N_PHASES = 13;
constexpr int TAIL0 = 8192, NTAIL = MV - TAIL0;
constexpr int LDS_BYTES = 147456;
constexpr int LDS_MISC_OFF = 135168;
typedef short bf16x8_t __attribute__((ext_vector_type(8)));

#define XB_TMO      128
#define XB_XCNT(j)  (256  + 64 * (j))
#define XB_XSUB(j)  (1280 + 64 * (j))
#define XB_XGEN(j)  (2304 + 64 * (j))
#define XB_TOP      3328
#define XB_TOPGEN   3392
#define XCD_BAR_WORDS 3456
#define XB_SPIN_CAP (1u << 18)

__device__ __forceinline__ unsigned xb_ld(unsigned* p)              { return __hip_atomic_load(p, __ATOMIC_RELAXED, __HIP_MEMORY_SCOPE_AGENT); }
__device__ __forceinline__ unsigned xb_add(unsigned* p, unsigned v) { return __hip_atomic_fetch_add(p, v, __ATOMIC_RELAXED, __HIP_MEMORY_SCOPE_AGENT); }
__device__ __forceinline__ unsigned xb_xcc_id() { return (unsigned)__builtin_amdgcn_s_getreg((3 << 11) | 20) & 0xFu; }
#define XB_SPIN(cond, bar) do { unsigned _sp = 0; while (cond) { __builtin_amdgcn_s_sleep(1); \
    if ((++_sp & 255u) == 0u) { if (xb_ld(&(bar)[XB_TMO])) break; if (_sp > XB_SPIN_CAP) { atomicAdd(&(bar)[XB_TMO], 1u); break; } } } } while (0)

struct XcdBarrier {
    unsigned* bar; unsigned x;
    volatile LAS unsigned* st;
};

__device__ __forceinline__ XcdBarrier xcd_barrier_post(unsigned* bar, volatile LAS unsigned* st) {
    XcdBarrier b; b.bar = bar; b.x = xb_xcc_id(); b.st = st;
    if (threadIdx.x == 0) (void)xb_add(&bar[XB_XCNT(b.x)], 1u);
    return b;
}
__device__ __forceinline__ void xcd_barrier_complete(unsigned* bar, unsigned x, unsigned& nloc, unsigned& nx) {
    const unsigned G = gridDim.x * gridDim.y * gridDim.z;
    unsigned sum, cnt, mine, sp = 0u;
    for (;;) {
        sum = 0u; cnt = 0u; mine = 0u;
#pragma unroll
        for (unsigned j = 0; j < 16; ++j) { const unsigned c = xb_ld(&bar[XB_XCNT(j)]); sum += c; cnt += (c > 0u) ? 1u : 0u; mine = (j == x) ? c : mine; }
        if (sum == G) break;
        __builtin_amdgcn_s_sleep(1);
        if ((++sp & 255u) == 0u) { if (xb_ld(&bar[XB_TMO])) break; if (sp > XB_SPIN_CAP) { atomicAdd(&bar[XB_TMO], 1u); break; } }
    }
    nloc = mine > 0u ? mine : 1u; nx = cnt > 0u ? cnt : 1u;
}

__device__ __forceinline__ void xcd_barrier(const XcdBarrier& b) {
    asm volatile("s_waitcnt vmcnt(0)" ::: "memory");
    __syncthreads();
    if (threadIdx.x == 0) {
        unsigned* bar = b.bar;
        __builtin_amdgcn_s_waitcnt(0);
        unsigned nloc = b.st[0], nx = b.st[1];
        if (nloc == 0u) { xcd_barrier_complete(bar, b.x, nloc, nx); b.st[0] = nloc; b.st[1] = nx; }
        const unsigned old = xb_add(&bar[XB_XSUB(b.x)], 1u);
        const unsigned gen = old / nloc;
        if (old + 1u == (gen + 1u) * nloc) {
            __builtin_amdgcn_fence(__ATOMIC_RELEASE, "agent");
            asm volatile("s_waitcnt vmcnt(0)" ::: "memory");
            const unsigned og = xb_add(&bar[XB_TOP], 1u);
            const unsigned tg = og / nx;
            if (og + 1u == (tg + 1u) * nx) xb_add(&bar[XB_TOPGEN], 1u);
            else XB_SPIN(xb_ld(&bar[XB_TOPGEN]) == tg, bar);
            __builtin_amdgcn_fence(__ATOMIC_ACQUIRE, "agent");
            xb_add(&bar[XB_XGEN(b.x)], 1u);
            asm volatile("s_waitcnt vmcnt(0)" ::: "memory");
        } else {
            XB_SPIN(xb_ld(&bar[XB_XGEN(b.x)]) == gen, bar);
            __builtin_amdgcn_fence(__ATOMIC_ACQUIRE, "agent");
            asm volatile("s_waitcnt vmcnt(0)" ::: "memory");
        }
    }
    __syncthreads();
}

#ifndef FLAT_BARRIER
#define FLAT_BARRIER 0
#endif
__device__ __forceinline__ void flat_barrier(unsigned* cnt) {
    asm volatile("s_waitcnt vmcnt(0)" ::: "memory");
    __syncthreads();
    if (threadIdx.x == 0) {
        const unsigned G = gridDim.x;
        __builtin_amdgcn_fence(__ATOMIC_RELEASE, "agent");
        asm volatile("s_waitcnt vmcnt(0)" ::: "memory");
        const unsigned old = __hip_atomic_fetch_add(cnt, 1u, __ATOMIC_RELAXED, __HIP_MEMORY_SCOPE_AGENT);
        const unsigned target = (old / G + 1u) * G;
        unsigned sp = 0u;
        while (__hip_atomic_load(cnt, __ATOMIC_RELAXED, __HIP_MEMORY_SCOPE_AGENT) < target) { __builtin_amdgcn_s_sleep(1); if (++sp > (1u << 24)) break; }
        __builtin_amdgcn_fence(__ATOMIC_ACQUIRE, "agent");
        asm volatile("s_waitcnt vmcnt(0)" ::: "memory");
    }
    __syncthreads();
}

constexpr size_t al256(size_t x) { return (x + 255) & ~(size_t)255; }
constexpr size_t WS_BAR = 0, BAR_ZERO_BYTES = 16384;
constexpr size_t WS_SS = 16384;
constexpr size_t WS_WUP1 = 262144;
constexpr size_t SZ_WUP = (size_t)2 * DFF * DM * 2, SZ_WDN = (size_t)DM * DFF * 2, SZ_WIN = (size_t)DIN * DM * 2, SZ_WC = (size_t)DM * DCONV * 2, SZ_WO = (size_t)DM * DM * 2;
constexpr size_t WS_WDN1 = WS_WUP1 + SZ_WUP, WS_WIN = WS_WDN1 + SZ_WDN, WS_WC = WS_WIN + SZ_WIN, WS_WA = WS_WC + SZ_WC, WS_WO = WS_WA + SZ_WC, WS_WUP2 = WS_WO + SZ_WO, WS_WDN2 = WS_WUP2 + SZ_WUP;
constexpr size_t WS_XB = WS_WDN2 + SZ_WDN;
constexpr size_t SZ_XB = (size_t)MPAD * DM * 2;
constexpr size_t WS_YA_OLD = WS_XB;
constexpr size_t WS_Z = WS_XB + SZ_XB;
constexpr size_t SZ_Z = (size_t)MPAD * DIN * 2;
constexpr size_t WS_ACT = WS_Z;
constexpr size_t WS_X1 = WS_Z + SZ_Z;
constexpr size_t WS_END = WS_X1 + (size_t)MPAD * DM * 4;
constexpr size_t WS_YA = WS_X1, WS_AT = WS_X1 + SZ_XB / 2;
constexpr size_t WS_MIX = WS_WUP1;
static_assert(SZ_XB <= SZ_WUP && (size_t)MPAD * DFF * 2 <= SZ_Z, "aliases");

struct Args { const float* in[21]; float* out; unsigned char* ws; int ph_lo, ph_hi; };

__device__ __forceinline__ float wave_sum(float v) {
#pragma unroll
    for (int o = 1; o < 64; o <<= 1) v += __shfl_xor(v, o);
    return v;
}
__device__ __forceinline__ unsigned pk2(float lo, float hi) { return pg8::cvt_pk_bf16(lo, hi); }

__device__ __forceinline__ void p0_x_row(const float* xrow, bf16_t* orow, float* ssp, int lane, bool zero) {
    const f32x4_t* xr = (const f32x4_t*)xrow + lane;
    float s = 0.f; unsigned long long* o8 = (unsigned long long*)orow + lane;
#pragma unroll
    for (int j = 0; j < 8; ++j) {
        f32x4_t v = zero ? (f32x4_t){0.f, 0.f, 0.f, 0.f} : xr[64 * j];
        s += (v.x * v.x + v.y * v.y) + (v.z * v.z + v.w * v.w);
        o8[64 * j] = (unsigned long long)pk2(v.x, v.y) | ((unsigned long long)pk2(v.z, v.w) << 32);
    }
    s = wave_sum(s);
    if (lane == 0) *ssp = s;
}

constexpr int KS_PITCH = 72, VT_PITCH = 264, LDS_KS = 0, LDS_VT = 256 * KS_PITCH * 2;
constexpr float LOG2E = 1.4426950408889634f;

__device__ __forceinline__ void attn_head(const u32x4_t qa, const u32x4_t qc, int h, int iq, int qrow, int kb0, int smin, int smax, int r, int quad,
                                          const float* qg, const float* sinks, bf16_t* attn, LAS unsigned char* lds) {
    const float slope2 = __builtin_amdgcn_exp2f(-0.5f * (float)(h + 1)) * LOG2E, sink2 = sinks[h] * LOG2E;
    bf16x8_t qf[2];
    {
        float q0[8] = {bf_lo(qa.x), bf_hi(qa.x), bf_lo(qa.y), bf_hi(qa.y), bf_lo(qa.z), bf_hi(qa.z), bf_lo(qa.w), bf_hi(qa.w)};
        float q1[8] = {bf_lo(qc.x), bf_hi(qc.x), bf_lo(qc.y), bf_hi(qc.y), bf_lo(qc.z), bf_hi(qc.z), bf_lo(qc.w), bf_hi(qc.w)};
        float ssq = 0.f;
#pragma unroll
        for (int i = 0; i < 8; ++i) ssq += q0[i] * q0[i] + q1[i] * q1[i];
        ssq += __shfl_xor(ssq, 16); ssq += __shfl_xor(ssq, 32);
        const float rq = __builtin_amdgcn_rsqf(ssq * (1.0f / HD) + EPSN) * (0.125f * LOG2E);
        const f32x4_t g0a = *(const f32x4_t*)(qg + 8 * quad), g0b = *(const f32x4_t*)(qg + 8 * quad + 4), g1a = *(const f32x4_t*)(qg + 32 + 8 * quad), g1b = *(const f32x4_t*)(qg + 32 + 8 * quad + 4);
        u32x4_t p0, p1;
        p0.x = pk2(q0[0] * rq * g0a.x, q0[1] * rq * g0a.y); p0.y = pk2(q0[2] * rq * g0a.z, q0[3] * rq * g0a.w); p0.z = pk2(q0[4] * rq * g0b.x, q0[5] * rq * g0b.y); p0.w = pk2(q0[6] * rq * g0b.z, q0[7] * rq * g0b.w);
        p1.x = pk2(q1[0] * rq * g1a.x, q1[1] * rq * g1a.y); p1.y = pk2(q1[2] * rq * g1a.z, q1[3] * rq * g1a.w); p1.z = pk2(q1[4] * rq * g1b.x, q1[5] * rq * g1b.y); p1.w = pk2(q1[6] * rq * g1b.z, q1[7] * rq * g1b.w);
        qf[0] = __builtin_bit_cast(bf16x8_t, p0); qf[1] = __builtin_bit_cast(bf16x8_t, p1);
    }
    f32x4_t sc[10];
    const LAS unsigned char* kbase = lds + LDS_KS + (kb0 * 16 + r) * (KS_PITCH * 2) + quad * 16;
    float mx = -1e30f;
    const unsigned srange = (unsigned)(smax - smin);
#pragma unroll
    for (int kk = 0; kk < 9; ++kk) {
        const bf16x8_t k0 = *(const LAS bf16x8_t*)(kbase + kk * 16 * (KS_PITCH * 2)), k1 = *(const LAS bf16x8_t*)(kbase + kk * 16 * (KS_PITCH * 2) + 64);
        f32x4_t a = (f32x4_t){0.f, 0.f, 0.f, 0.f};
        a = __builtin_amdgcn_mfma_f32_16x16x32_bf16(k0, qf[0], a, 0, 0, 0);
        a = __builtin_amdgcn_mfma_f32_16x16x32_bf16(k1, qf[1], a, 0, 0, 0);
#pragma unroll
        for (int v = 0; v < 4; ++v) {
            const int s = 16 * (kb0 + kk) + 4 * quad + v, dist = 128 + iq - s;
            const bool ok = ((unsigned)dist <= 128u) && ((unsigned)(s - smin) < srange);
            const float x = ok ? a[v] - slope2 * (float)dist : -1e30f;
            a[v] = x; mx = fmaxf(mx, x);
        }
        sc[kk] = a;
        __builtin_amdgcn_sched_barrier(0);
    }
    mx = fmaxf(mx, __shfl_xor(mx, 16)); mx = fmaxf(mx, __shfl_xor(mx, 32)); mx = fmaxf(mx, sink2);
    float sum = 0.f;
#pragma unroll
    for (int kk = 0; kk < 9; ++kk)
#pragma unroll
        for (int v = 0; v < 4; ++v) { const float p = __builtin_amdgcn_exp2f(sc[kk][v] - mx); sc[kk][v] = p; sum += p; }
    sc[9] = (f32x4_t){0.f, 0.f, 0.f, 0.f};
    sum += __shfl_xor(sum, 16); sum += __shfl_xor(sum, 32);
    sum += __builtin_amdgcn_exp2f(sink2 - mx);
    const float inv = 1.0f / sum;
    f32x4_t o[4] = {(f32x4_t){0.f, 0.f, 0.f, 0.f}, (f32x4_t){0.f, 0.f, 0.f, 0.f}, (f32x4_t){0.f, 0.f, 0.f, 0.f}, (f32x4_t){0.f, 0.f, 0.f, 0.f}};
    const LAS unsigned char* vbase = lds + LDS_VT + (r * VT_PITCH + 16 * kb0 + 4 * quad) * 2;
#pragma unroll
    for (int ks = 0; ks < 5; ++ks) {
        u32x4_t pw; pw.x = pk2(sc[2 * ks][0], sc[2 * ks][1]); pw.y = pk2(sc[2 * ks][2], sc[2 * ks][3]); pw.z = pk2(sc[2 * ks + 1][0], sc[2 * ks + 1][1]); pw.w = pk2(sc[2 * ks + 1][2], sc[2 * ks + 1][3]);
        const bf16x8_t pf = __builtin_bit_cast(bf16x8_t, pw);
#pragma unroll
        for (int db = 0; db < 4; ++db) {
            const LAS unsigned char* vp = vbase + (db * 16 * VT_PITCH + 32 * ks) * 2;
            const u32x2_t lo2 = *(const LAS u32x2_t*)vp, hi2 = *(const LAS u32x2_t*)(vp + (ks < 4 ? 32 : 0));
            const u32x4_t vw = (u32x4_t){lo2.x, lo2.y, hi2.x, hi2.y};
            o[db] = __builtin_amdgcn_mfma_f32_16x16x32_bf16(__builtin_bit_cast(bf16x8_t, vw), pf, o[db], 0, 0, 0);
        }
        __builtin_amdgcn_sched_barrier(0);
    }
    bf16_t* op = attn + (size_t)qrow * QDIM + h * HD + 4 * quad;
#pragma unroll
    for (int db = 0; db < 4; ++db) { u32x2_t wv; wv.x = pk2(o[db][0] * inv, o[db][1] * inv); wv.y = pk2(o[db][2] * inv, o[db][3] * inv); *(u32x2_t*)(op + 16 * db) = wv; }
}

__device__ __forceinline__ void attn_unit(int kind, int b, int kh, int j, const bf16_t* z, const float* cache_k, const float* cache_v,
                                          const float* qg, const float* kg, const float* sinks, bf16_t* attn, float* out, LAS unsigned char* lds) {
    const int tid = threadIdx.x, lane = tid & 63, w = tid >> 6;
    int r = lane & 15, quad = lane >> 4;
    asm volatile("" : "+v"(r), "+v"(quad));
    bool active; int iq, gl, qrow, smin, smax;
    if (kind == 0) { active = !(j == 0 && w < 7); iq = 16 * w + r; gl = 0; qrow = b * LP + 128 * j + iq - 112; smin = (j == 0) ? 240 : (j == 1 ? 112 : 0); smax = 256; }
    else { active = (w == 0); iq = r >> 2; gl = r & 3; qrow = MP + b * DECT + iq; smin = 0; smax = NWIN + DECT; }
    u32x4_t qa[4], qc[4];
#pragma unroll
    for (int p = 0; p < 4; ++p) { qa[p] = (u32x4_t){0u, 0u, 0u, 0u}; qc[p] = (u32x4_t){0u, 0u, 0u, 0u}; }
    if (active) {
#pragma unroll
        for (int p = 0; p < 4; ++p) if (kind == 0 || p == 0) {
            const bf16_t* zq = z + (size_t)qrow * DIN + ZO_Q + (kh * 4 + (kind == 0 ? p : gl)) * HD + 8 * quad;
            qa[p] = *(const u32x4_t*)zq; qc[p] = *(const u32x4_t*)(zq + 32);
        }
    }
    {
        const int s = tid >> 1, hf = tid & 1;
        bool valid, need_norm = true; int row = 0;
        if (kind == 0) { const int tk = 128 * (j - 1) + s - 112; valid = tk >= 0; row = b * LP + tk; }
        else { valid = s < NWIN + DECT; need_norm = (s >= NWIN); row = MP + b * DECT + (s - NWIN); }
        const bool from_cache = (kind == 1 && s < NWIN);
        size_t oo = 0; bool wr_out = false;
        if (kind == 0) { if (j == 16 && s >= 128) { oo = ((size_t)(b * NWIN + (s - 128)) * NKV + kh) * HD + 32 * hf; wr_out = true; } }
        else { if (s >= DECT && s < NWIN + DECT) { oo = ((size_t)(b * NWIN + (s - DECT)) * NKV + kh) * HD + 32 * hf; wr_out = true; } }
        const size_t coff = ((size_t)(b * NWIN + s) * NKV + kh) * HD + 32 * hf;
        float kv[32], vv[32];
        if (!valid) {
#pragma unroll
            for (int i = 0; i < 32; ++i) { kv[i] = 0.f; vv[i] = 0.f; }
        } else if (from_cache) {
            const f32x4_t* ck = (const f32x4_t*)(cache_k + coff); const f32x4_t* cv = (const f32x4_t*)(cache_v + coff);
#pragma unroll
            for (int i = 0; i < 8; ++i) { const f32x4_t a = ck[i], c = cv[i]; kv[4 * i] = a.x; kv[4 * i + 1] = a.y; kv[4 * i + 2] = a.z; kv[4 * i + 3] = a.w; vv[4 * i] = c.x; vv[4 * i + 1] = c.y; vv[4 * i + 2] = c.z; vv[4 * i + 3] = c.w; }
        } else {
            const u32x4_t* zk = (const u32x4_t*)(z + (size_t)row * DIN + ZO_K + kh * HD + 32 * hf); const u32x4_t* zv = (const u32x4_t*)(z + (size_t)row * DIN + ZO_V + kh * HD + 32 * hf);
#pragma unroll
            for (int i = 0; i < 4; ++i) { const u32x4_t a = zk[i], c = zv[i];
                kv[8 * i] = bf_lo(a.x); kv[8 * i + 1] = bf_hi(a.x); kv[8 * i + 2] = bf_lo(a.y); kv[8 * i + 3] = bf_hi(a.y); kv[8 * i + 4] = bf_lo(a.z); kv[8 * i + 5] = bf_hi(a.z); kv[8 * i + 6] = bf_lo(a.w); kv[8 * i + 7] = bf_hi(a.w);
                vv[8 * i] = bf_lo(c.x); vv[8 * i + 1] = bf_hi(c.x); vv[8 * i + 2] = bf_lo(c.y); vv[8 * i + 3] = bf_hi(c.y); vv[8 * i + 4] = bf_lo(c.z); vv[8 * i + 5] = bf_hi(c.z); vv[8 * i + 6] = bf_lo(c.w); vv[8 * i + 7] = bf_hi(c.w); }
        }
        float ssq = 0.f;
#pragma unroll
        for (int i = 0; i < 32; ++i) ssq += kv[i] * kv[i];
        ssq += __shfl_xor(ssq, 1);
        if (valid && need_norm) {
            const float rinv = __builtin_amdgcn_rsqf(ssq * (1.0f / HD) + EPSN);
#pragma unroll
            for (int i = 0; i < 8; ++i) { const f32x4_t gg = *(const f32x4_t*)(kg + 32 * hf + 4 * i);
                kv[4 * i] *= rinv * gg.x; kv[4 * i + 1] *= rinv * gg.y; kv[4 * i + 2] *= rinv * gg.z; kv[4 * i + 3] *= rinv * gg.w; }
        }
        if (wr_out) { float* ko = out + ((kind == 0) ? OUT_KP : OUT_KS) + oo; float* vo = out + ((kind == 0) ? OUT_VP : OUT_VS) + oo;
#pragma unroll
            for (int i = 0; i < 8; ++i) { ((f32x4_t*)ko)[i] = (f32x4_t){kv[4 * i], kv[4 * i + 1], kv[4 * i + 2], kv[4 * i + 3]}; ((f32x4_t*)vo)[i] = (f32x4_t){vv[4 * i], vv[4 * i + 1], vv[4 * i + 2], vv[4 * i + 3]}; } }
        LAS u32x4_t* kd = (LAS u32x4_t*)(lds + LDS_KS + s * (KS_PITCH * 2) + hf * 64);
#pragma unroll
        for (int i = 0; i < 4; ++i) { u32x4_t o; o.x = pk2(kv[8 * i], kv[8 * i + 1]); o.y = pk2(kv[8 * i + 2], kv[8 * i + 3]); o.z = pk2(kv[8 * i + 4], kv[8 * i + 5]); o.w = pk2(kv[8 * i + 6], kv[8 * i + 7]); kd[i] = o; }
        LAS bf16_t* vt = (LAS bf16_t*)(lds + LDS_VT);
#pragma unroll
        for (int i = 0; i < 32; i += 2) { const unsigned p = pk2(vv[i], vv[i + 1]); vt[(32 * hf + i) * VT_PITCH + s] = (bf16_t)(p & 0xffffu); vt[(32 * hf + i + 1) * VT_PITCH + s] = (bf16_t)(p >> 16); }
    }
    __syncthreads();
    asm volatile("" : "+v"(iq));
    if (active) {
        const int kb0 = (kind == 0) ? w : 0;
#pragma unroll
        for (int p = 0; p < 4; ++p) if (kind == 0 || p == 0) {
            attn_head(qa[p], qc[p], kh * 4 + (kind == 0 ? p : gl), iq, qrow, kb0, smin, smax, r, quad, qg, sinks, attn, lds);
            __builtin_amdgcn_sched_barrier(0);
        }
    }
    __syncthreads();
}

__device__ __forceinline__ void load_u8(const bf16_t* z, int row, int c, float (&u)[8]) {
    const u32x4_t xc = *(const u32x4_t*)(z + (size_t)row * DIN + ZO_XC + c), cg_ = *(const u32x4_t*)(z + (size_t)row * DIN + ZO_CG + c);
    u[0] = bf_lo(xc.x) * bf_lo(cg_.x); u[1] = bf_hi(xc.x) * bf_hi(cg_.x); u[2] = bf_lo(xc.y) * bf_lo(cg_.y); u[3] = bf_hi(xc.y) * bf_hi(cg_.y);
    u[4] = bf_lo(xc.z) * bf_lo(cg_.z); u[5] = bf_hi(xc.z) * bf_hi(cg_.z); u[6] = bf_lo(xc.w) * bf_lo(cg_.w); u[7] = bf_hi(xc.w) * bf_hi(cg_.w);
}
__device__ __forceinline__ void load_f8(const float* p, float (&u)[8]) {
    const f32x4_t a = *(const f32x4_t*)p, b = *(const f32x4_t*)(p + 4);
    u[0] = a.x; u[1] = a.y; u[2] = a.z; u[3] = a.w; u[4] = b.x; u[5] = b.y; u[6] = b.z; u[7] = b.w;
}
__device__ __forceinline__ void conv_item(int ci, const bf16_t* z, const float* state, const float* cw, bf16_t* ya, float* out) {
    const int tid = threadIdx.x, c = (tid & 127) * 8, rsub = tid >> 7, rbase = 32 * ci + 8 * rsub;
    float w0[8], w1[8], w2[8];
    load_f8(cw + c, w0); load_f8(cw + DCONV + c, w1); load_f8(cw + 2 * DCONV + c, w2);
    u32x4_t xcw[10], cgw[10], bgw[8];
#pragma unroll
    for (int i = 0; i < 10; ++i) { const int row = rbase - 2 + i; const int rc = row < 0 ? 0 : row;
        xcw[i] = *(const u32x4_t*)(z + (size_t)rc * DIN + ZO_XC + c); cgw[i] = *(const u32x4_t*)(z + (size_t)rc * DIN + ZO_CG + c); }
#pragma unroll
    for (int i = 0; i < 8; ++i) bgw[i] = *(const u32x4_t*)(z + (size_t)(rbase + i) * DIN + ZO_BG + c);
    float u[10][8];
#pragma unroll
    for (int i = 0; i < 10; ++i) {
        const u32x4_t xc = xcw[i], cg_ = cgw[i];
        u[i][0] = bf_lo(xc.x) * bf_lo(cg_.x); u[i][1] = bf_hi(xc.x) * bf_hi(cg_.x); u[i][2] = bf_lo(xc.y) * bf_lo(cg_.y); u[i][3] = bf_hi(xc.y) * bf_hi(cg_.y);
        u[i][4] = bf_lo(xc.z) * bf_lo(cg_.z); u[i][5] = bf_hi(xc.z) * bf_hi(cg_.z); u[i][6] = bf_lo(xc.w) * bf_lo(cg_.w); u[i][7] = bf_hi(xc.w) * bf_hi(cg_.w);
    }
#pragma unroll
    for (int i = 0; i < 8; ++i) {
        const int row = rbase + i;
        int t, sq; const bool samp = row >= MP;
        if (!samp) { sq = row / LP; t = row - sq * LP; } else { sq = (row - MP) / DECT; t = (row - MP) - sq * DECT; }
        float u1[8], u2[8];
        if (t >= 1) {
#pragma unroll
            for (int e = 0; e < 8; ++e) u1[e] = u[i + 1][e];
        } else if (samp) load_f8(state + ((size_t)sq * 2 + 1) * DCONV + c, u1);
        else {
#pragma unroll
            for (int e = 0; e < 8; ++e) u1[e] = 0.f;
        }
        if (t >= 2) {
#pragma unroll
            for (int e = 0; e < 8; ++e) u2[e] = u[i][e];
        } else if (samp) load_f8(state + ((size_t)sq * 2 + t) * DCONV + c, u2);
        else {
#pragma unroll
            for (int e = 0; e < 8; ++e) u2[e] = 0.f;
        }
        const u32x4_t bw = bgw[i];
        const float bg[8] = {bf_lo(bw.x), bf_hi(bw.x), bf_lo(bw.y), bf_hi(bw.y), bf_lo(bw.z), bf_hi(bw.z), bf_lo(bw.w), bf_hi(bw.w)};
        float y[8];
#pragma unroll
        for (int e = 0; e < 8; ++e) y[e] = bg[e] * (w0[e] * u2[e] + w1[e] * u1[e] + w2[e] * u[i + 2][e]);
        u32x4_t o; o.x = pk2(y[0], y[1]); o.y = pk2(y[2], y[3]); o.z = pk2(y[4], y[5]); o.w = pk2(y[6], y[7]);
        *(u32x4_t*)(ya + (size_t)row * DCONV + c) = o;
        float* no = nullptr;
        if (!samp) { if (t >= LP - 2) no = out + OUT_CP + ((size_t)sq * 2 + (t - (LP - 2))) * DCONV + c; }
        else { if (t >= DECT - 2) no = out + OUT_CS + ((size_t)sq * 2 + (t - (DECT - 2))) * DCONV + c; }
        if (no) { *(f32x4_t*)no = (f32x4_t){u[i + 2][0], u[i + 2][1], u[i + 2][2], u[i + 2][3]}; *(f32x4_t*)(no + 4) = (f32x4_t){u[i + 2][4], u[i + 2][5], u[i + 2][6], u[i + 2][7]}; }
    }
}

template <int MODE> __device__ __forceinline__ void fix_resid(const float* part, int nsl, const float* xp, const float* xs, const float* meta, float* xbuf, bf16_t* xb, float* ss, float* out, int gw, int ngw, int lane) {
    for (int it = gw; it < NTAIL * 8; it += ngw) {
        const int rloc = it >> 3, row = TAIL0 + rloc, col = (it & 7) * 256 + lane * 4;
        const bf16_t* p = (const bf16_t*)part + (size_t)rloc * 2048 + col;
        f32x4_t v = (f32x4_t){0.f, 0.f, 0.f, 0.f};
#pragma unroll 8
        for (int s = 0; s < nsl; ++s) { const u32x2_t w = __builtin_nontemporal_load((const u32x2_t*)(p + (size_t)s * (256 * 2048))); v += (f32x4_t){bf_lo(w.x), bf_hi(w.x), bf_lo(w.y), bf_hi(w.y)}; }
        const float scale = (MODE == 1) ? 1.0f : 0.5f;
        const u32x2_t bw = *(const u32x2_t*)(xb + (size_t)row * DM + col);
        const f32x4_t o = (f32x4_t){bf_lo(bw.x), bf_hi(bw.x), bf_lo(bw.y), bf_hi(bw.y)} + v * scale;
        if (MODE == 2) { float* dst = y_row(out, row); if (dst) __builtin_nontemporal_store(o, (f32x4_t*)(dst + col)); }
        else {
            u32x2_t w; w.x = pk2(o.x, o.y); w.y = pk2(o.z, o.w); *(u32x2_t*)(xb + (size_t)row * DM + col) = w;
            const float sq = wave_sum((o.x * o.x + o.y * o.y) + (o.z * o.z + o.w * o.w));
            if (lane == 0) __hip_atomic_fetch_add(ss + row, sq, __ATOMIC_RELAXED, __HIP_MEMORY_SCOPE_AGENT);
        }
    }
}
__device__ __forceinline__ void fix_gate(const float* part, int nsl, const bf16_t* z, bf16_t* mixed, int gw, int ngw, int lane) {
    for (int it = gw; it < NTAIL * 8; it += ngw) {
        const int rloc = it >> 3, row = TAIL0 + rloc, col = (it & 7) * 256 + lane * 4;
        const bf16_t* p = (const bf16_t*)part + (size_t)rloc * 2048 + col;
        f32x4_t a = (f32x4_t){0.f, 0.f, 0.f, 0.f}, b = (f32x4_t){0.f, 0.f, 0.f, 0.f};
#pragma unroll 8
        for (int s = 0; s < nsl; ++s) { const u32x2_t wa = __builtin_nontemporal_load((const u32x2_t*)(p + (size_t)s * (256 * 2048))), wb = __builtin_nontemporal_load((const u32x2_t*)(p + (size_t)(s + nsl) * (256 * 2048)));
            a += (f32x4_t){bf_lo(wa.x), bf_hi(wa.x), bf_lo(wa.y), bf_hi(wa.y)}; b += (f32x4_t){bf_lo(wb.x), bf_hi(wb.x), bf_lo(wb.y), bf_hi(wb.y)}; }
        const u32x2_t gc = *(const u32x2_t*)(z + (size_t)row * DIN + ZO_GC + col), ga = *(const u32x2_t*)(z + (size_t)row * DIN + ZO_GA + col);
        u32x2_t w;
        w.x = pk2(bf_lo(gc.x) * a.x + bf_lo(ga.x) * b.x, bf_hi(gc.x) * a.y + bf_hi(ga.x) * b.y);
        w.y = pk2(bf_lo(gc.y) * a.z + bf_lo(ga.y) * b.z, bf_hi(gc.y) * a.w + bf_hi(ga.y) * b.w);
        *(u32x2_t*)(mixed + (size_t)row * DM + col) = w;
    }
}

constexpr int I_UP = (DM / 64) * (2 * DFF / 64), I_DN = (DFF / 64) * (DM / 64), I_IN = (DM / 64) * (DIN / 64), I_C = (DCONV / 64) * (DM / 64), I_O = (DM / 64) * (DM / 64);
constexpr int CI_DN1 = I_UP, CI_IN = CI_DN1 + I_DN, CI_C = CI_IN + I_IN, CI_A = CI_C + I_C, CI_O = CI_A + I_C, CI_UP2 = CI_O + I_O, CI_DN2 = CI_UP2 + I_UP, CI_END = CI_DN2 + I_DN;
struct CvtItem { const float* src; const float* gp; bf16_t* dst; int N, K; };
__device__ __forceinline__ void cvt_decode(int it, int lane, const Args& args, CvtItem& d) {
    const float* W; const float* gain = nullptr; int K, N, mode = 0, item, blk = 0; size_t wo;
    if (it < CI_DN1)      { W = args.in[7];  K = DM;    N = 2 * DFF; wo = WS_WUP1; gain = args.in[6];  mode = 1; item = it; blk = 1; }
    else if (it < CI_IN)  { W = args.in[8];  K = DFF;   N = DM;      wo = WS_WDN1; item = it - CI_DN1; blk = 1; }
    else if (it < CI_C)   { W = args.in[10]; K = DM;    N = DIN;     wo = WS_WIN;  gain = args.in[9];  item = it - CI_IN; blk = 1; }
    else if (it < CI_A)   { W = args.in[14]; K = DCONV; N = DM;      wo = WS_WC;   item = it - CI_C; }
    else if (it < CI_O)   { W = args.in[16]; K = QDIM;  N = DM;      wo = WS_WA;   item = it - CI_A; }
    else if (it < CI_UP2) { W = args.in[17]; K = DM;    N = DM;      wo = WS_WO;   item = it - CI_O; }
    else if (it < CI_DN2) { W = args.in[19]; K = DM;    N = 2 * DFF; wo = WS_WUP2; gain = args.in[18]; mode = 1; item = it - CI_UP2; blk = 1; }
    else                  { W = args.in[20]; K = DFF;   N = DM;      wo = WS_WDN2; item = it - CI_DN2; blk = 1; }
    const int nblk = N / 64, kb = item / nblk, nb = item - kb * nblk, k0 = 64 * kb, n0 = 64 * nb;
    int nd0 = n0;
    if (mode == 1) { if (n0 < DFF) nd0 = 256 * (n0 / 128) + (n0 % 128); else { const int j = n0 - DFF; nd0 = 256 * (j / 128) + 128 + (j % 128); } }
    d.src = W + (size_t)(k0 + (lane >> 4)) * N + n0 + (lane & 15) * 4;
    d.gp = gain ? gain + k0 + (lane >> 4) : nullptr;
    const int nrow = nd0 + (lane >> 3);
    if (blk) { d.dst = (bf16_t*)(args.ws + wo) + (((size_t)(nrow >> 8) * (K / 64) + kb) * 256 + (nrow & 255)) * 64 + 8 * (lane & 7); d.K = 64; }
    else { d.dst = (bf16_t*)(args.ws + wo) + (size_t)nrow * K + k0 + 8 * (lane & 7); d.K = K; }
    d.N = N;
}
__device__ __forceinline__ void cvt_load(const CvtItem& d, f32x4_t (&v)[16], float (&g)[16]) {
#pragma unroll
    for (int i = 0; i < 16; ++i) { v[i] = __builtin_nontemporal_load((const f32x4_t*)(d.src + (size_t)(4 * i) * d.N)); g[i] = d.gp ? d.gp[4 * i] : 1.0f; }
}
__device__ __forceinline__ void convert_range(int lo_it, int hi_it, int gw, int ngw, LAS unsigned char* lds, int wave, int lane_in, const Args& args) {
    int lane = lane_in; asm volatile("" : "+v"(lane));
    LAS float* scr = (LAS float*)(lds + wave * 16640);
    int it = lo_it + gw;
    if (it >= hi_it) return;
    CvtItem cur; f32x4_t v[16]; float g[16];
    cvt_decode(it, lane, args, cur); cvt_load(cur, v, g);
#pragma unroll 1
    for (;;) {
        const int itn = it + ngw; const bool more = itn < hi_it;
        CvtItem nxt = cur; f32x4_t vn[16]; float gn[16];
        if (more) { cvt_decode(itn, lane, args, nxt); cvt_load(nxt, vn, gn); }
        LAS float* d = scr + (lane >> 4) * 65 + (lane & 15) * 4;
#pragma unroll
        for (int i = 0; i < 16; ++i) { const f32x4_t x = v[i] * g[i]; LAS float* dd = d + (4 * i) * 65; dd[0] = x.x; dd[1] = x.y; dd[2] = x.z; dd[3] = x.w; }
        asm volatile("s_waitcnt lgkmcnt(0)" ::: "memory");
        const LAS float* s = scr + (8 * (lane & 7)) * 65 + (lane >> 3);
#pragma unroll
        for (int j = 0; j < 8; ++j) { const LAS float* sj = s + 8 * j;
            u32x4_t o; o.x = pk2(sj[0 * 65], sj[1 * 65]); o.y = pk2(sj[2 * 65], sj[3 * 65]); o.z = pk2(sj[4 * 65], sj[5 * 65]); o.w = pk2(sj[6 * 65], sj[7 * 65]);
            *(u32x4_t*)(cur.dst + (size_t)(8 * j) * cur.K) = o; }
        asm volatile("s_waitcnt lgkmcnt(0)" ::: "memory");
        if (!more) break;
        it = itn; cur = nxt;
#pragma unroll
        for (int i = 0; i < 16; ++i) { v[i] = vn[i]; g[i] = gn[i]; }
    }
}

__global__ void __launch_bounds__(NWAVES * 64, 2) fwd_megakernel(Args args) {
    extern __shared__ __attribute__((aligned(16))) unsigned char lds_raw[];
    LAS unsigned char* lds = (LAS unsigned char*)lds_raw;
    const int tid = threadIdx.x, lane = tid & 63, wave = __builtin_amdgcn_readfirstlane(tid >> 6);
    const int G = gridDim.x, bx = blockIdx.x;
    unsigned char* ws = args.ws;
    const float* x_prompt = args.in[0]; const float* x_sample = args.in[1]; const float* state_conv = args.in[2]; const float* cache_k = args.in[3]; const float* cache_v = args.in[4];
    const float* meta = args.in[5]; const float* g_ffn1 = args.in[6]; const float* w_up1 = args.in[7]; const float* w_dn1 = args.in[8]; const float* g_mix = args.in[9];
    const float* w_in = args.in[10]; const float* q_g = args.in[11]; const float* k_g = args.in[12]; const float* conv_w = args.in[13]; const float* w_conv_out = args.in[14];
    const float* sinks = args.in[15]; const float* w_attn_out = args.in[16]; const float* w_o = args.in[17]; const float* g_ffn2 = args.in[18]; const float* w_up2 = args.in[19]; const float* w_dn2 = args.in[20];
    float* out = args.out;
    float* ss0 = (float*)(ws + WS_SS); float* ss1 = ss0 + MPAD; float* ss2 = ss1 + MPAD;
    bf16_t* Wup1 = (bf16_t*)(ws + WS_WUP1); bf16_t* Wdn1 = (bf16_t*)(ws + WS_WDN1); bf16_t* Win = (bf16_t*)(ws + WS_WIN); bf16_t* Wc = (bf16_t*)(ws + WS_WC); bf16_t* Wa = (bf16_t*)(ws + WS_WA);
    bf16_t* Wo = (bf16_t*)(ws + WS_WO); bf16_t* Wup2 = (bf16_t*)(ws + WS_WUP2); bf16_t* Wdn2 = (bf16_t*)(ws + WS_WDN2);
    bf16_t* xb = (bf16_t*)(ws + WS_XB); bf16_t* ya = (bf16_t*)(ws + WS_YA); bf16_t* at = (bf16_t*)(ws + WS_AT); bf16_t* zb = (bf16_t*)(ws + WS_Z); bf16_t* act = (bf16_t*)(ws + WS_ACT);
    float* x1 = (float*)(ws + WS_X1); bf16_t* mixed = (bf16_t*)(ws + WS_MIX);
    const int lo = args.ph_lo, hi = args.ph_hi;
    const int GG_UP = (G >= 64) ? G - 16 : G / 2, GG_IN = (G >= 64) ? G - 24 : G / 2;
    if (hi > 1000) cg::this_grid().sync();
    if (tid < 2) ((volatile LAS unsigned*)(lds + LDS_MISC_OFF))[tid] = 0u;
    __syncthreads();
    XcdBarrier bar = xcd_barrier_post((unsigned*)(ws + WS_BAR), (volatile LAS unsigned*)(lds + LDS_MISC_OFF));
#ifndef PH_MASK
#define PH_MASK 0x1fff
#endif
#define IN(k) (((PH_MASK >> (k)) & 1) && lo <= (k) && (k) < hi)
#define SEAM(k) do { if (IN(k) && IN((k) + 1)) { if (FLAT_BARRIER) flat_barrier((unsigned*)(ws + WS_BAR) + 64); else xcd_barrier(bar); } } while (0)

    for (int rep_ = 0; rep_ < ((PROBE_DUP == 1) ? 2 : 1); ++rep_)
    if (IN(0)) {
        const int gw = bx * NWAVES + wave, NGW = G * NWAVES;
        convert_range(0, CI_DN1, gw, NGW, lds, wave, lane, args);
        for (int m = gw; m < MPAD; m += 2 * NGW) {
            const int m2 = m + NGW; const bool has2 = m2 < MPAD, za = m >= MV, zb_ = (!has2) || m2 >= MV;
            const f32x4_t* xa = (const f32x4_t*)x0_row(x_prompt, x_sample, meta, m) + lane;
            const f32x4_t* xc = (const f32x4_t*)x0_row(x_prompt, x_sample, meta, has2 ? m2 : m) + lane;
            f32x4_t va[8], vb[8];
#pragma unroll
            for (int j = 0; j < 8; ++j) { va[j] = za ? (f32x4_t){0.f, 0.f, 0.f, 0.f} : xa[64 * j]; vb[j] = zb_ ? (f32x4_t){0.f, 0.f, 0.f, 0.f} : xc[64 * j]; }
            float sa = 0.f, sb = 0.f;
            unsigned long long* oa = (unsigned long long*)(xb + (size_t)m * DM) + lane; unsigned long long* ob = (unsigned long long*)(xb + (size_t)(has2 ? m2 : m) * DM) + lane;
#pragma unroll
            for (int j = 0; j < 8; ++j) {
                sa += (va[j].x * va[j].x + va[j].y * va[j].y) + (va[j].z * va[j].z + va[j].w * va[j].w);
                sb += (vb[j].x * vb[j].x + vb[j].y * vb[j].y) + (vb[j].z * vb[j].z + vb[j].w * vb[j].w);
                oa[64 * j] = (unsigned long long)pk2(va[j].x, va[j].y) | ((unsigned long long)pk2(va[j].z, va[j].w) << 32);
                if (has2) ob[64 * j] = (unsigned long long)pk2(vb[j].x, vb[j].y) | ((unsigned long long)pk2(vb[j].z, vb[j].w) << 32);
            }
            sa = wave_sum(sa); sb = wave_sum(sb);
            if (lane == 0) { ss0[m] = sa; ss1[m] = 0.f; ss2[m] = 0.f; if (has2) { ss0[m2] = sb; ss1[m2] = 0.f; ss2[m2] = 0.f; } }
        }
    }
    SEAM(0);
    if (PROBE_DUP == 3) { for (int rep_ = 0; rep_ < 16; ++rep_) SEAM(0); }
    const int gw = bx * NWAVES + wave, NGW = G * NWAVES;
    float* part_o = out;
    float* part_w = (float*)(ws + WS_WDN1);
    for (int rep_ = 0; rep_ < ((PROBE_DUP == 4) ? 2 : 1); ++rep_)
    if (IN(1)) {
        if (bx < GG_UP) { pg8::Gemm g{xb, Wup1, MPAD, 2 * DFF, DM, nullptr, 0, 1}; pg8::StaticOrder S; S.init(MPAD, 2 * DFF, DM, GG_UP, bx);
            pg8::EpiSwiglu E{act, ss0};
            pg8::gemm_phase<pg8::EpiSwiglu, pg8::StaticOrder, true, true>(lds, g, S, E); }
        else convert_range(CI_DN1, CI_C, (bx - GG_UP) * NWAVES + wave, (G - GG_UP) * NWAVES, lds, wave, lane, args);
    }
    SEAM(1);
    if (IN(2)) {
        pg8::Gemm g{act, Wdn1, MPAD, DM, DFF, part_o, 1, 1}; pg8::TailOrder S; S.init(DFF, 32, 0, G, bx);
        pg8::EpiResid<0> E{x_prompt, x_sample, meta, x1, xb, ss1, out};
        pg8::gemm_phase<pg8::EpiResid<0>, pg8::TailOrder, true, true>(lds, g, S, E);
    }
    SEAM(2);
    if (IN(3)) fix_resid<0>(part_o, 32, x_prompt, x_sample, meta, x1, xb, ss1, out, gw, NGW, lane);
    SEAM(3);
    for (int rep_ = 0; rep_ < ((PROBE_DUP == 5) ? 2 : 1); ++rep_)
    if (IN(4)) {
        if (bx < GG_IN) { pg8::Gemm g{xb, Win, MPAD, DIN, DM, nullptr, 0, 1}; pg8::StaticOrder S; S.init(MPAD, DIN, DM, GG_IN, bx);
            pg8::EpiZ E{zb, ss1};
            pg8::gemm_phase<pg8::EpiZ, pg8::StaticOrder, true, true>(lds, g, S, E); }
        else convert_range(CI_C, CI_DN2, (bx - GG_IN) * NWAVES + wave, (G - GG_IN) * NWAVES, lds, wave, lane, args);
    }
    SEAM(4);
    for (int rep_ = 0; rep_ < ((PROBE_DUP == 2) ? 2 : 1); ++rep_)
    if (IN(5)) {
        constexpr int N_PH = NB * NKV * 16, N_PL = NB * NKV, N_SA = DECB * NKV, N_CV = MV / 32, N_IT = N_PH + N_PL + N_SA + N_CV;
        for (int it = bx; it < N_IT; it += G) {
            if (it < N_PH + N_PL) { const int bk = (it < N_PH) ? (it >> 4) : (it - N_PH), j = (it < N_PH) ? 1 + (it & 15) : 0; attn_unit(0, bk >> 2, bk & 3, j, zb, cache_k, cache_v, q_g, k_g, sinks, at, out, lds); }
            else if (it < N_PH + N_PL + N_SA) { const int u = it - N_PH - N_PL; attn_unit(1, u >> 2, u & 3, 0, zb, cache_k, cache_v, q_g, k_g, sinks, at, out, lds); }
            else conv_item(it - N_PH - N_PL - N_SA, zb, state_conv, conv_w, ya, out);
        }
    }
    SEAM(5);
    if (IN(6)) {
#pragma unroll 1
        for (int pass = 0; pass < 2; ++pass) {
            pg8::Gemm g{pass ? at : ya, pass ? Wa : Wc, MPAD, DM, DCONV, (float*)((bf16_t*)part_o + (size_t)pass * 8 * 256 * 2048), 0, 0}; pg8::TailOrder S; S.init(DCONV, 8, pass * 64, G, bx);
            pg8::EpiGate E{mixed, zb, pass};
            pg8::gemm_phase<pg8::EpiGate, pg8::TailOrder, true, true>(lds, g, S, E);
        }
    }
    SEAM(6);
    if (IN(7)) fix_gate(part_o, 8, zb, mixed, gw, NGW, lane);
    SEAM(7);
    if (IN(8)) {
        pg8::Gemm g{mixed, Wo, MPAD, DM, DM, part_o, 0, 0}; pg8::TailOrder S; S.init(DM, 16, 0, G, bx);
        pg8::EpiResid<1> E{x_prompt, x_sample, meta, x1, xb, ss2, out};
        pg8::gemm_phase<pg8::EpiResid<1>, pg8::TailOrder, true, true>(lds, g, S, E);
    }
    SEAM(8);
    if (IN(9)) fix_resid<1>(part_o, 16, x_prompt, x_sample, meta, x1, xb, ss2, out, gw, NGW, lane);
    SEAM(9);
    if (IN(10)) {
        if (bx < GG_UP) { pg8::Gemm g{xb, Wup2, MPAD, 2 * DFF, DM, nullptr, 0, 1}; pg8::StaticOrder S; S.init(MPAD, 2 * DFF, DM, GG_UP, bx);
            pg8::EpiSwiglu E{act, ss2};
            pg8::gemm_phase<pg8::EpiSwiglu, pg8::StaticOrder, true, true>(lds, g, S, E); }
        else convert_range(CI_DN2, CI_END, (bx - GG_UP) * NWAVES + wave, (G - GG_UP) * NWAVES, lds, wave, lane, args);
    }
    SEAM(10);
    for (int rep_ = 0; rep_ < ((PROBE_DUP == 6) ? 2 : 1); ++rep_) {
    if (rep_ == 1) { if (FLAT_BARRIER) flat_barrier((unsigned*)(ws + WS_BAR) + 64); else xcd_barrier(bar); }
    if (IN(11)) {
        pg8::Gemm g{act, Wdn2, MPAD, DM, DFF, part_w, 1, 1}; pg8::TailOrder S; S.init(DFF, 32, 0, G, bx);
        pg8::EpiResid<2> E{x_prompt, x_sample, meta, x1, xb, ss2, out};
        pg8::gemm_phase<pg8::EpiResid<2>, pg8::TailOrder, true, true>(lds, g, S, E);
    }
    SEAM(11);
    if (IN(12)) fix_resid<2>(part_w, 32, x_prompt, x_sample, meta, x1, xb, ss2, out, gw, NGW, lane);
    }
#undef IN
#undef SEAM
}

extern "C" void kernel_launch(void* const* d_in, const int* in_sizes, int n_in, void* d_out, int out_size, void* d_ws, size_t ws_size, hipStream_t stream) {
    static int grid = 0;
    if (grid == 0) {
        if (n_in != 21 || out_size != (int)OUT_END || ws_size < WS_END) { fprintf(stderr, "kernel_launch: unexpected shapes: n_in %d out %d ws %zu (need %zu)\n", n_in, out_size, ws_size, (size_t)WS_END); grid = -1; return; }
        int dev = 0, cus = 0, per_cu = 0;
        if (hipGetDevice(&dev) != hipSuccess || hipDeviceGetAttribute(&cus, hipDeviceAttributeMultiprocessorCount, dev) != hipSuccess) { grid = -1; return; }
        if (hipFuncSetAttribute((const void*)fwd_megakernel, hipFuncAttributeMaxDynamicSharedMemorySize, LDS_BYTES) != hipSuccess) { fprintf(stderr, "kernel_launch: hipFuncSetAttribute failed\n"); grid = -1; return; }
        if (hipOccupancyMaxActiveBlocksPerMultiprocessor(&per_cu, (const void*)fwd_megakernel, NWAVES * 64, LDS_BYTES) != hipSuccess || per_cu < 1) { fprintf(stderr, "kernel_launch: occupancy query says %d\n", per_cu); per_cu = 1; }
        (void)hipGetLastError();
        grid = cus;
    }
    if (grid < 0) return;
    if (hipMemsetAsync((char*)d_ws + WS_BAR, 0, BAR_ZERO_BYTES, stream) != hipSuccess) { fprintf(stderr, "kernel_launch: memset failed\n"); return; }
    Args a{};
    for (int i = 0; i < 21; ++i) a.in[i] = (const float*)d_in[i];
    a.out = (float*)d_out; a.ws = (unsigned char*)d_ws;
    if (MK_N_LAUNCHES == 1) {
        a.ph_lo = 0; a.ph_hi = N_PHASES;
        void* kargs[] = {&a};
        const hipError_t e = hipLaunchCooperativeKernel((const void*)fwd_megakernel, dim3(grid), dim3(NWAVES * 64), kargs, LDS_BYTES, stream);
        if (e != hipSuccess) fprintf(stderr, "kernel_launch: cooperative launch failed: %s (grid %d)\n", hipGetErrorString(e), grid);
    } else {
        for (int p = 0; p < N_PHASES; ++p) { a.ph_lo = p; a.ph_hi = p + 1; hipLaunchKernelGGL(fwd_megakernel, dim3(grid), dim3(NWAVES * 64), LDS_BYTES, stream, a); }
    }
}
```

```cpp
#include <hip/hip_runtime.h>
#include <hip/hip_cooperative_groups.h>
#include <cstdio>
#include <cstdint>
namespace cg = cooperative_groups;

constexpr int DM = 2048, NB = 4, SEQ = 2048, NMETA = 16, LP = SEQ + NMETA, DECB = 32, DECT = 4;
constexpr int MP = NB * LP  , MS = DECB * DECT  , MV = MP + MS  , MPAD = 8448;
constexpr int DCONV = 1024, HD = 64, NH = 16, NKV = 4, QDIM = 1024, KVDIM = 256, DFF = 5504, DIN = 8704, NWIN = 128;
constexpr int ZO_XC = 0, ZO_BG = 1024, ZO_CG = 2048, ZO_Q = 3072, ZO_K = 4096, ZO_V = 4352, ZO_GC = 4608, ZO_GA = 6656;
constexpr float EPSN = 1e-6f;
constexpr size_t OUT_YP = 0, OUT_YS = 16777216, OUT_CP = 17039360, OUT_KP = 17047552, OUT_VP = 17178624, OUT_CS = 17309696, OUT_KS = 17375232, OUT_VS = 18423808, OUT_END = 19472384;

typedef unsigned short bf16_t;
#define LAS __attribute__((address_space(3)))
typedef unsigned u32x4_t __attribute__((ext_vector_type(4)));
typedef unsigned u32x2_t __attribute__((ext_vector_type(2)));
typedef float f32x4_t __attribute__((ext_vector_type(4)));

__device__ __forceinline__ const float* x0_row(const float* xp, const float* xs, const float* meta, int row) {
    if (row >= MV) row = MV - 1;
    if (row >= MP) return xs + (size_t)(row - MP) * DM;
    const int b = row / LP, t = row - b * LP;
    return t < NMETA ? meta + (size_t)t * DM : xp + ((size_t)b * SEQ + (t - NMETA)) * DM;
}
__device__ __forceinline__ float* y_row(float* out, int row) {
    if (row >= MV) return nullptr;
    if (row >= MP) return out + OUT_YS + (size_t)(row - MP) * DM;
    const int b = row / LP, t = row - b * LP;
    if (t < NMETA) return nullptr;
    return out + OUT_YP + ((size_t)b * SEQ + (t - NMETA)) * DM;
}
__device__ __forceinline__ float bf_lo(unsigned w) { return __uint_as_float(w << 16); }
__device__ __forceinline__ float bf_hi(unsigned w) { return __uint_as_float(w & 0xffff0000u); }

namespace pg8 {
#define PG8_LAS __attribute__((address_space(3)))
typedef unsigned short bf16_t;
typedef short bf16x8 __attribute__((ext_vector_type(8)));
typedef float f32x4 __attribute__((ext_vector_type(4)));
typedef unsigned u32x4 __attribute__((ext_vector_type(4)));
constexpr int BM = 256, BK = 64, HALF = 128, HTB = HALF * BK * 2  , STAGE_BYTES = 8 * HTB, NXCD = 8, WGM = 6;

__host__ __device__ __forceinline__ int lds_byte(int r, int c) { const int st = (r >> 4) * 2 + (c >> 5), rr = r & 15, cc = c & 31, ob = rr * 64 + cc * 2; return st * 1024 + (ob ^ (((ob >> 9) & 1) << 5)); }
__host__ __device__ __forceinline__ void stage_rc(int b, int& R, int& C) { const int st = b / 1024, sb = b % 1024, swz = sb ^ (((sb >> 9) & 1) << 5); R = (st >> 1) * 16 + swz / 64; C = (st & 1) * 32 + (swz % 64) / 2; }
__host__ __device__ __forceinline__ int perm32(int rho) { const int n = rho >> 4, i = rho & 15; return 8 * (i >> 2) + 4 * n + (i & 3); }

struct Unit { int pm, pn, k0, nk, part; };
struct Gemm { const bf16_t* A; const bf16_t* Bt; int M, N, K; float* part; int a_blk, b_blk; };

struct StaticOrder {
    int nM, nN, nwg, G, c, nkf;
    __host__ __device__ void init(int M, int N, int K, int G_, int c_) { nM = M / BM; nN = N / BM; nwg = nM * nN; G = G_; c = c_; nkf = K / BK; }
    __host__ __device__ bool next(int i, Unit& u) const {
        const long L = (long)i * G + c; const int xcd = (int)(L % NXCD), off = (int)(L / NXCD);
        const int b0 = xcd == 0 ? 0 : ((xcd * nwg / NXCD + WGM / 2) / WGM) * WGM, b1 = xcd == NXCD - 1 ? nwg : (((xcd + 1) * nwg / NXCD + WGM / 2) / WGM) * WGM;
        if (b0 + off >= b1) return false;
        const int wgid = b0 + off;
        const int nig = WGM * nN, gid = wgid / nig, fm = gid * WGM, gsz = (nM - fm) < WGM ? (nM - fm) : WGM;
        u.pm = fm + ((wgid % nig) % gsz); u.pn = (wgid % nig) / gsz; u.k0 = 0; u.nk = nkf; u.part = -1; return true;
    }
    __device__ __forceinline__ void a_ready(const Unit&) const {}
    __device__ __forceinline__ void done(const Unit&) const {}
};

struct TailOrder {
    int G, c, nkf, nsl, poff;
    __host__ __device__ void init(int K, int nsl_, int poff_, int G_, int c_) { G = G_; c = c_; nkf = K / BK; nsl = nsl_; poff = poff_; }
    __host__ __device__ bool next(int i, Unit& u) const {
        const long L = (long)i * G + c;
        if (L < 256) {
            const int xcd = (int)L % NXCD, off = (int)L / NXCD;
            u.pm = xcd * 4 + (off & 3); u.pn = off >> 2; u.k0 = 0; u.nk = nkf; u.part = -1; return true;
        }
        const long p = L - 256 - poff; if (p < 0 || p >= 8 * nsl) return false;
        const int sl = (int)p / 8, pairs = nkf / 2, base = pairs / nsl, rem = pairs % nsl;
        u.pm = 32; u.pn = (int)p % 8; u.k0 = 2 * (sl * base + (sl < rem ? sl : rem)); u.nk = 2 * (base + (sl < rem ? 1 : 0)); u.part = sl; return true;
    }
    __device__ __forceinline__ void a_ready(const Unit&) const {}
    __device__ __forceinline__ void done(const Unit&) const {}
};
__device__ __forceinline__ unsigned cvt_pk_bf16(float lo, float hi) { unsigned r; asm volatile("v_cvt_pk_bf16_f32 %0, %1, %2" : "=v"(r) : "v"(lo), "v"(hi)); return r; }
__device__ __forceinline__ float silu_mul(float g, float u) { return g * __builtin_amdgcn_rcpf(1.0f + __builtin_amdgcn_exp2f(-1.4426950408889634f * g)) * u; }
__device__ __forceinline__ float sigmoidf_(float v) { return __builtin_amdgcn_rcpf(1.0f + __builtin_amdgcn_exp2f(-1.4426950408889634f * v)); }

struct EpiSwiglu {
    static constexpr bool PERM = true, AFTER_DRAIN = false;
    bf16_t* act; const float* ss;
    __device__ __forceinline__ void operator()(const f32x4 (&acc)[2][2][4][2], const Unit& u, int wr, int wc, int fr, int fq) const {
        const int row0 = u.pm * BM + wr * 64 + fr, j0 = u.pn * HALF + wc * 32 + 8 * fq;
        float rs[2][4];
#pragma unroll
        for (int ai = 0; ai < 2; ++ai)
#pragma unroll
            for (int m = 0; m < 4; ++m) rs[ai][m] = ss[row0 + ai * HALF + m * 16];
        __builtin_amdgcn_sched_barrier(0);
#pragma unroll
        for (int ai = 0; ai < 2; ++ai)
#pragma unroll
            for (int m = 0; m < 4; ++m) {
                const int row = row0 + ai * HALF + m * 16;
                const float r = __builtin_amdgcn_rsqf(rs[ai][m] * (1.0f / DM) + EPSN);
                const f32x4 g0 = acc[ai][0][m][0] * r, g1 = acc[ai][0][m][1] * r, u0 = acc[ai][1][m][0] * r, u1 = acc[ai][1][m][1] * r;
                u32x4 w;
                w.x = cvt_pk_bf16(silu_mul(g0[0], u0[0]), silu_mul(g0[1], u0[1])); w.y = cvt_pk_bf16(silu_mul(g0[2], u0[2]), silu_mul(g0[3], u0[3]));
                w.z = cvt_pk_bf16(silu_mul(g1[0], u1[0]), silu_mul(g1[1], u1[1])); w.w = cvt_pk_bf16(silu_mul(g1[2], u1[2]), silu_mul(g1[3], u1[3]));
                *(u32x4*)(act + (((size_t)u.pm * (DFF / 64) + (u.pn * 2 + (wc >> 1))) * 256 + (row - u.pm * BM)) * 64 + (wc & 1) * 32 + 8 * fq) = w;
                __builtin_amdgcn_sched_barrier(0);
            }
    }
};

struct EpiZ {
    static constexpr bool PERM = true, AFTER_DRAIN = false;
    bf16_t* z; const float* ss;
    __device__ __forceinline__ void operator()(const f32x4 (&acc)[2][2][4][2], const Unit& u, int wr, int wc, int fr, int fq) const {
        const int row0 = u.pm * BM + wr * 64 + fr, col0 = u.pn * BM + wc * 32 + 8 * fq;
        const bool sig = (u.pn * BM >= ZO_GC);
        float rs[2][4];
#pragma unroll
        for (int ai = 0; ai < 2; ++ai)
#pragma unroll
            for (int m = 0; m < 4; ++m) rs[ai][m] = ss[row0 + ai * HALF + m * 16];
        __builtin_amdgcn_sched_barrier(0);
#pragma unroll
        for (int ai = 0; ai < 2; ++ai)
#pragma unroll
            for (int m = 0; m < 4; ++m) {
                const int row = row0 + ai * HALF + m * 16;
                const float r = __builtin_amdgcn_rsqf(rs[ai][m] * (1.0f / DM) + EPSN);
#pragma unroll
                for (int bj = 0; bj < 2; ++bj) {
                    f32x4 v0 = acc[ai][bj][m][0] * r, v1 = acc[ai][bj][m][1] * r;
                    if (sig) {
#pragma unroll
                        for (int i = 0; i < 4; ++i) { v0[i] = sigmoidf_(v0[i]); v1[i] = sigmoidf_(v1[i]); }
                    }
                    u32x4 w; w.x = cvt_pk_bf16(v0[0], v0[1]); w.y = cvt_pk_bf16(v0[2], v0[3]); w.z = cvt_pk_bf16(v1[0], v1[1]); w.w = cvt_pk_bf16(v1[2], v1[3]);
                    *(u32x4*)(z + (size_t)row * DIN + col0 + bj * HALF) = w;
                }
                __builtin_amdgcn_sched_barrier(0);
            }
    }
};

struct EpiGate {
    static constexpr bool PERM = true, AFTER_DRAIN = false;
    bf16_t* mixed; const bf16_t* z; int PASS;
    __device__ __forceinline__ void operator()(const f32x4 (&acc)[2][2][4][2], const Unit& u, int wr, int wc, int fr, int fq) const {
        const int row0 = u.pm * BM + wr * 64 + fr, col0 = u.pn * BM + wc * 32 + 8 * fq;
        const int zo = PASS ? ZO_GA : ZO_GC;
#pragma unroll
        for (int ai = 0; ai < 2; ++ai) {
            u32x4 gw[4][2], pw[4][2];
#pragma unroll
            for (int m = 0; m < 4; ++m)
#pragma unroll
                for (int bj = 0; bj < 2; ++bj) {
                    const int row = row0 + ai * HALF + m * 16, c = col0 + bj * HALF;
                    gw[m][bj] = *(const u32x4*)(z + (size_t)row * DIN + zo + c);
                    pw[m][bj] = PASS ? *(const u32x4*)(mixed + (size_t)row * DM + c) : (u32x4){0u, 0u, 0u, 0u};
                }
            __builtin_amdgcn_sched_barrier(0);
#pragma unroll
            for (int m = 0; m < 4; ++m) {
                const int row = row0 + ai * HALF + m * 16;
#pragma unroll
                for (int bj = 0; bj < 2; ++bj) {
                    const int c = col0 + bj * HALF;
                    const u32x4 g = gw[m][bj], p = pw[m][bj];
                    f32x4 v0 = acc[ai][bj][m][0], v1 = acc[ai][bj][m][1];
                    v0[0] = v0[0] * bf_lo(g.x) + bf_lo(p.x); v0[1] = v0[1] * bf_hi(g.x) + bf_hi(p.x); v0[2] = v0[2] * bf_lo(g.y) + bf_lo(p.y); v0[3] = v0[3] * bf_hi(g.y) + bf_hi(p.y);
                    v1[0] = v1[0] * bf_lo(g.z) + bf_lo(p.z); v1[1] = v1[1] * bf_hi(g.z) + bf_hi(p.z); v1[2] = v1[2] * bf_lo(g.w) + bf_lo(p.w); v1[3] = v1[3] * bf_hi(g.w) + bf_hi(p.w);
                    u32x4 w; w.x = cvt_pk_bf16(v0[0], v0[1]); w.y = cvt_pk_bf16(v0[2], v0[3]); w.z = cvt_pk_bf16(v1[0], v1[1]); w.w = cvt_pk_bf16(v1[2], v1[3]);
                    *(u32x4*)(mixed + (size_t)row * DM + c) = w;
                }
                __builtin_amdgcn_sched_barrier(0);
            }
        }
    }
};

template <int MODE> struct EpiResid {
    static constexpr bool PERM = false, AFTER_DRAIN = false;
    const float* xp; const float* xs; const float* meta; float* xbuf; bf16_t* xb; float* ss; float* out;
    __device__ __forceinline__ void operator()(const f32x4 (&acc)[2][2][4][2], const Unit& u, int wr, int wc, int fr, int fq) const {
        const int row0 = u.pm * BM + wr * 64 + fr, col0 = u.pn * BM + wc * 32 + 4 * fq;
        const float scale = (MODE == 1) ? 1.0f : 0.5f;
#pragma unroll
        for (int ai = 0; ai < 2; ++ai) {
            u32x2_t bw[4][2][2];
#pragma unroll
            for (int m = 0; m < 4; ++m) {
                const bf16_t* base = xb + (size_t)(row0 + ai * HALF + m * 16) * DM + col0;
#pragma unroll
                for (int bj = 0; bj < 2; ++bj)
#pragma unroll
                    for (int n = 0; n < 2; ++n) bw[m][bj][n] = *(const u32x2_t*)(base + bj * HALF + n * 16);
            }
            __builtin_amdgcn_sched_barrier(0);
#pragma unroll
            for (int m = 0; m < 4; ++m) {
                const int row = row0 + ai * HALF + m * 16;
                float* dst = (MODE == 2) ? y_row(out, row) : nullptr;
                float sq = 0.f;
#pragma unroll
                for (int bj = 0; bj < 2; ++bj)
#pragma unroll
                    for (int n = 0; n < 2; ++n) {
                        const int c = col0 + bj * HALF + n * 16;
                        const u32x2_t w0 = bw[m][bj][n];
                        const f32x4 o = (f32x4){bf_lo(w0.x), bf_hi(w0.x), bf_lo(w0.y), bf_hi(w0.y)} + acc[ai][bj][m][n] * scale;
                        if (MODE == 2) { if (dst) __builtin_nontemporal_store(o, (f32x4*)(dst + c)); }
                        else {
                            u32x2_t w; w.x = cvt_pk_bf16(o[0], o[1]); w.y = cvt_pk_bf16(o[2], o[3]);
                            *(u32x2_t*)(xb + (size_t)row * DM + c) = w;
                            sq += (o[0] * o[0] + o[1] * o[1]) + (o[2] * o[2] + o[3] * o[3]);
                        }
                    }
                if (MODE != 2) {
                    sq += __shfl_xor(sq, 16); sq += __shfl_xor(sq, 32);
                    if (fq == 0) __hip_atomic_fetch_add(ss + row, sq, __ATOMIC_RELAXED, __HIP_MEMORY_SCOPE_AGENT);
                }
                __builtin_amdgcn_sched_barrier(0);
            }
        }
    }
};

template <bool PERM> __device__ __forceinline__ void store_part(const f32x4 (&acc)[2][2][4][2], const Unit& u, float* part, int wr, int wc, int fr, int fq) {
    bf16_t* base = (bf16_t*)part + (size_t)u.part * (256 * 2048);
    int rl0 = wr * 64 + fr; const int col0 = u.pn * BM + wc * 32 + (PERM ? 8 * fq : 4 * fq);
    asm volatile("" : "+v"(rl0));
#pragma unroll
    for (int ai = 0; ai < 2; ++ai)
#pragma unroll
        for (int m = 0; m < 4; ++m) {
            bf16_t* rp = base + (size_t)(rl0 + ai * HALF + m * 16) * 2048 + col0;
#pragma unroll
            for (int bj = 0; bj < 2; ++bj)
#pragma unroll
                for (int n = 0; n < 2; ++n) { const f32x4 v = acc[ai][bj][m][n]; u32x2_t w; w.x = cvt_pk_bf16(v[0], v[1]); w.y = cvt_pk_bf16(v[2], v[3]);
                    *(u32x2_t*)(rp + bj * HALF + (PERM ? 4 * n : 16 * n)) = w; }
            __builtin_amdgcn_sched_barrier(0);
        }
}

template <class Epi, class Sched, bool ALIGN_EPI = false, bool SP2 = false>
__device__ __forceinline__ void gemm_phase(PG8_LAS unsigned char* lds, const Gemm g, const Sched& S, const Epi& E) {
    const int tid = threadIdx.x, wid = __builtin_amdgcn_readfirstlane(tid >> 6), lane = tid & 63, wr = wid >> 2, wc = wid & 3, fr = lane & 15, fq = lane >> 4;
    const int K = g.K;
    const int pitchA = g.a_blk ? BK : K, pitchB = g.b_blk ? BK : K;
    unsigned voffA[2], voffB[2];
#pragma unroll
    for (int i = 0; i < 2; ++i) { int R, C; stage_rc(tid * 16 + i * 8192, R, C); const int Rb = Epi::PERM ? ((R & ~31) + perm32(R & 31)) : R;
        voffA[i] = (unsigned)(R * pitchA + C) * 2u; voffB[i] = (unsigned)(Rb * pitchB + C) * 2u; }
    const size_t kstepA = g.a_blk ? (size_t)(BM * BK * 2) : (size_t)(BK * 2), kstepB = g.b_blk ? (size_t)(BM * BK * 2) : (size_t)(BK * 2);
    const size_t hstepA = (size_t)HALF * pitchA * 2, hstepB = (size_t)HALF * pitchB * 2;
    const size_t tstep = (size_t)BM * K * 2;
    const unsigned ldsw = (unsigned)wid * 1024u;
    const int aoff = lds_byte(wr * 64 + fr, fq * 8), boff = lds_byte(wc * 32 + fr, fq * 8);
#define PG8_SA(b, h) (((b) * 2 + (h)) * HTB)
#define PG8_SB(b, h) ((4 + (b) * 2 + (h)) * HTB)
#define PG8_STAGE(bufoff, gbase, voff) do { _Pragma("unroll") for (int _i = 0; _i < 2; ++_i) \
        __builtin_amdgcn_global_load_lds((const unsigned*)((const char*)(gbase) + (voff)[_i]), (PG8_LAS unsigned*)(lds + (bufoff) + ldsw + _i * 8192), 16, 0, 0); } while (0)
#define PG8_LDA(dst, b, h) do { _Pragma("unroll") for (int m = 0; m < 4; ++m) _Pragma("unroll") for (int k = 0; k < 2; ++k) dst[m][k] = *(const PG8_LAS bf16x8*)(lds + PG8_SA(b, h) + aoff + m * 2048 + k * 1024); } while (0)
#define PG8_LDB(dst, b, h) do { _Pragma("unroll") for (int n = 0; n < 2; ++n) _Pragma("unroll") for (int k = 0; k < 2; ++k) dst[n][k] = *(const PG8_LAS bf16x8*)(lds + PG8_SB(b, h) + boff + n * 2048 + k * 1024); } while (0)
#define PG8_MMA(ai, bj, At, Bt) do { __builtin_amdgcn_s_setprio(1); _Pragma("unroll") for (int m = 0; m < 4; ++m) _Pragma("unroll") for (int n = 0; n < 2; ++n) _Pragma("unroll") for (int k = 0; k < 2; ++k) \
        acc[ai][bj][m][n] = __builtin_amdgcn_mfma_f32_16x16x32_bf16(Bt[n][k], At[m][k], acc[ai][bj][m][n], 0, 0, 0); __builtin_amdgcn_s_setprio(0); } while (0)
#define PG8_WAIT_V(n) asm volatile("s_waitcnt vmcnt(" #n ")" ::: "memory")
#define PG8_WAIT_L(n) asm volatile("s_waitcnt lgkmcnt(" #n ")" ::: "memory")
#define PG8_BAR __builtin_amdgcn_s_barrier()
#define PG8_SCHED __builtin_amdgcn_sched_barrier(0)
    Unit cur, nxt; int ui = 0;
    if (!S.next(0, cur)) return;
    int nt = cur.nk;
    f32x4 acc[2][2][4][2];
#pragma unroll
    for (int a = 0; a < 2; ++a)
#pragma unroll
        for (int b = 0; b < 2; ++b)
#pragma unroll
            for (int m = 0; m < 4; ++m)
#pragma unroll
                for (int n = 0; n < 2; ++n) acc[a][b][m][n] = (f32x4){0.f, 0.f, 0.f, 0.f};
    bf16x8 At[4][2], B0[2][2], B1[2][2];
    const char* cA = (const char*)g.A + (size_t)cur.pm * tstep + (size_t)cur.k0 * kstepA; const char* cB = (const char*)g.Bt + (size_t)cur.pn * tstep + (size_t)cur.k0 * kstepB;
    S.a_ready(cur);
    if constexpr (SP2) {
        PG8_STAGE(PG8_SB(0, 0), cB, voffB); PG8_STAGE(PG8_SB(0, 1), cB + hstepB, voffB); PG8_STAGE(PG8_SA(0, 0), cA, voffA); PG8_STAGE(PG8_SA(0, 1), cA + hstepA, voffA);
        if (wr == 1) PG8_BAR;
        PG8_WAIT_V(2); PG8_BAR;
        PG8_STAGE(PG8_SB(1, 0), cB + kstepB, voffB); PG8_STAGE(PG8_SA(1, 0), cA + kstepA, voffA); PG8_STAGE(PG8_SB(1, 1), cB + hstepB + kstepB, voffB);
        PG8_WAIT_V(6); PG8_BAR;
    } else {
        PG8_STAGE(PG8_SB(0, 0), cB, voffB); PG8_STAGE(PG8_SA(0, 0), cA, voffA); PG8_STAGE(PG8_SB(0, 1), cB + hstepB, voffB); PG8_STAGE(PG8_SA(0, 1), cA + hstepA, voffA);
        if (wr == 1) PG8_BAR;
        PG8_WAIT_V(4); PG8_BAR;
        PG8_STAGE(PG8_SB(1, 0), cB + kstepB, voffB); PG8_STAGE(PG8_SA(1, 0), cA + kstepA, voffA); PG8_STAGE(PG8_SB(1, 1), cB + hstepB + kstepB, voffB);
        PG8_WAIT_V(6); PG8_BAR;
    }
    for (;;) {
        const bool has_next = S.next(ui + 1, nxt);
        const char* nA = has_next ? (const char*)g.A + (size_t)nxt.pm * tstep + (size_t)nxt.k0 * kstepA : cA; const char* nB = has_next ? (const char*)g.Bt + (size_t)nxt.pn * tstep + (size_t)nxt.k0 * kstepB : cB;
        for (int t = 0; t < nt; t += 2) {
            const bool last = (t == nt - 2);
            const char* a1 = cA + (size_t)(t + 1) * kstepA;
            const char* a2 = last ? nA : cA + (size_t)(t + 2) * kstepA; const char* b2 = last ? nB : cB + (size_t)(t + 2) * kstepB;
            const char* a3 = a2 + kstepA; const char* b3 = b2 + kstepB;
            if (last && has_next) S.a_ready(nxt);
            if constexpr (SP2) {
            PG8_LDB(B0, 0, 0); PG8_LDB(B1, 0, 1); PG8_SCHED; PG8_LDA(At, 0, 0); PG8_STAGE(PG8_SA(1, 1), a1 + hstepA, voffA);
            PG8_WAIT_V(8); PG8_WAIT_L(0); PG8_BAR; PG8_MMA(0, 0, At, B0); PG8_MMA(0, 1, At, B1); PG8_BAR; PG8_SCHED;
            PG8_LDA(At, 0, 1); PG8_STAGE(PG8_SB(0, 0), b2, voffB); PG8_STAGE(PG8_SB(0, 1), b2 + hstepB, voffB); PG8_STAGE(PG8_SA(0, 0), a2, voffA);
            PG8_WAIT_V(8); PG8_WAIT_L(0); PG8_BAR; PG8_MMA(1, 0, At, B0); PG8_MMA(1, 1, At, B1); PG8_BAR; PG8_SCHED;
            PG8_LDB(B0, 1, 0); PG8_LDB(B1, 1, 1); PG8_SCHED; PG8_LDA(At, 1, 0); PG8_STAGE(PG8_SA(0, 1), a2 + hstepA, voffA);
            PG8_WAIT_V(8); PG8_WAIT_L(0); PG8_BAR; PG8_MMA(0, 0, At, B0); PG8_MMA(0, 1, At, B1); PG8_BAR; PG8_SCHED;
            PG8_LDA(At, 1, 1); PG8_STAGE(PG8_SB(1, 0), b3, voffB); PG8_STAGE(PG8_SB(1, 1), b3 + hstepB, voffB); PG8_STAGE(PG8_SA(1, 0), a3, voffA);
            PG8_WAIT_V(8); PG8_WAIT_L(0); PG8_BAR; PG8_MMA(1, 0, At, B0); PG8_MMA(1, 1, At, B1); PG8_BAR; PG8_SCHED;
            } else {
            PG8_LDB(B0, 0, 0); PG8_SCHED; PG8_LDA(At, 0, 0); PG8_STAGE(PG8_SA(1, 1), a1 + hstepA, voffA);
            PG8_WAIT_L(8); PG8_BAR; PG8_WAIT_L(0); PG8_MMA(0, 0, At, B0); PG8_BAR; PG8_SCHED;
            PG8_LDB(B1, 0, 1); PG8_STAGE(PG8_SB(0, 0), b2, voffB);
            PG8_BAR; PG8_WAIT_L(0); PG8_MMA(0, 1, At, B1); PG8_BAR;
            PG8_LDA(At, 0, 1); PG8_STAGE(PG8_SA(0, 0), a2, voffA);
            PG8_BAR; PG8_WAIT_L(0); PG8_MMA(1, 0, At, B0); PG8_BAR; PG8_SCHED;
            PG8_STAGE(PG8_SB(0, 1), b2 + hstepB, voffB);
            PG8_WAIT_V(6); PG8_BAR; PG8_MMA(1, 1, At, B1); PG8_BAR;
            PG8_LDB(B0, 1, 0); PG8_SCHED; PG8_LDA(At, 1, 0); PG8_STAGE(PG8_SA(0, 1), a2 + hstepA, voffA);
            PG8_WAIT_L(8); PG8_BAR; PG8_WAIT_L(0); PG8_MMA(0, 0, At, B0); PG8_BAR; PG8_SCHED;
            PG8_LDB(B1, 1, 1); PG8_STAGE(PG8_SB(1, 0), b3, voffB);
            PG8_BAR; PG8_WAIT_L(0); PG8_MMA(0, 1, At, B1); PG8_BAR;
            PG8_LDA(At, 1, 1); PG8_STAGE(PG8_SA(1, 0), a3, voffA);
            PG8_BAR; PG8_WAIT_L(0); PG8_MMA(1, 0, At, B0); PG8_BAR; PG8_SCHED;
            PG8_STAGE(PG8_SB(1, 1), b3 + hstepB, voffB);
            PG8_WAIT_V(6); PG8_BAR; PG8_MMA(1, 1, At, B1); PG8_BAR;
            }
        }
        if constexpr (ALIGN_EPI) { if (wr == 0) PG8_BAR; }
        if constexpr (!Epi::AFTER_DRAIN) { if (cur.part < 0) E(acc, cur, wr, wc, fr, fq); else store_part<Epi::PERM>(acc, cur, g.part, wr, wc, fr, fq); S.done(cur); }
        if (!has_next) break;
#pragma unroll
        for (int a = 0; a < 2; ++a)
#pragma unroll
            for (int b = 0; b < 2; ++b)
#pragma unroll
                for (int m = 0; m < 4; ++m)
#pragma unroll
                    for (int n = 0; n < 2; ++n) acc[a][b][m][n] = (f32x4){0.f, 0.f, 0.f, 0.f};
        cur = nxt; cA = nA; cB = nB; ++ui; nt = cur.nk;
        if constexpr (ALIGN_EPI) { if (wr == 1) PG8_BAR; }
    }
    PG8_WAIT_V(0);
    if constexpr (!ALIGN_EPI) { if (wr == 0) PG8_BAR; }
    PG8_BAR;
    if constexpr (Epi::AFTER_DRAIN) { E.fused(acc, cur, wr, wc, fr, fq, lds, wid, lane); S.done(cur); }
#undef PG8_SA
#undef PG8_SB
#undef PG8_STAGE
#undef PG8_LDA
#undef PG8_LDB
#undef PG8_MMA
#undef PG8_WAIT_V
#undef PG8_WAIT_L
#undef PG8_BAR
#undef PG8_SCHED
}
}

constexpr int NWAVES = 8;
#ifndef PROBE_DUP
#define PROBE_DUP 0
#endif
#ifndef MK_N_LAUNCHES
#define MK_N_LAUNCHES 1
#endif
constexpr int N_PHASES = 13;
constexpr int TAIL0 = 8192, NTAIL = MV - TAIL0;
constexpr int LDS_BYTES = 147456;
constexpr int LDS_MISC_OFF = 135168;
typedef short bf16x8_t __attribute__((ext_vector_type(8)));

#define XB_TMO      128
#define XB_XCNT(j)  (256  + 64 * (j))
#define XB_XSUB(j)  (1280 + 64 * (j))
#define XB_XGEN(j)  (2304 + 64 * (j))
#define XB_TOP      3328
#define XB_TOPGEN   3392
#define XCD_BAR_WORDS 3456
#define XB_SPIN_CAP (1u << 18)

__device__ __forceinline__ unsigned xb_ld(unsigned* p)              { return __hip_atomic_load(p, __ATOMIC_RELAXED, __HIP_MEMORY_SCOPE_AGENT); }
__device__ __forceinline__ unsigned xb_add(unsigned* p, unsigned v) { return __hip_atomic_fetch_add(p, v, __ATOMIC_RELAXED, __HIP_MEMORY_SCOPE_AGENT); }
__device__ __forceinline__ unsigned xb_xcc_id() { return (unsigned)__builtin_amdgcn_s_getreg((3 << 11) | 20) & 0xFu; }
#define XB_SPIN(cond, bar) do { unsigned _sp = 0; while (cond) { __builtin_amdgcn_s_sleep(1); \
    if ((++_sp & 255u) == 0u) { if (xb_ld(&(bar)[XB_TMO])) break; if (_sp > XB_SPIN_CAP) { atomicAdd(&(bar)[XB_TMO], 1u); break; } } } } while (0)

struct XcdBarrier {
    unsigned* bar; unsigned x;
    volatile LAS unsigned* st;
};

__device__ __forceinline__ XcdBarrier xcd_barrier_post(unsigned* bar, volatile LAS unsigned* st) {
    XcdBarrier b; b.bar = bar; b.x = xb_xcc_id(); b.st = st;
    if (threadIdx.x == 0) (void)xb_add(&bar[XB_XCNT(b.x)], 1u);
    return b;
}
__device__ __forceinline__ void xcd_barrier_complete(unsigned* bar, unsigned x, unsigned& nloc, unsigned& nx) {
    const unsigned G = gridDim.x * gridDim.y * gridDim.z;
    unsigned sum, cnt, mine, sp = 0u;
    for (;;) {
        sum = 0u; cnt = 0u; mine = 0u;
#pragma unroll
        for (unsigned j = 0; j < 16; ++j) { const unsigned c = xb_ld(&bar[XB_XCNT(j)]); sum += c; cnt += (c > 0u) ? 1u : 0u; mine = (j == x) ? c : mine; }
        if (sum == G) break;
        __builtin_amdgcn_s_sleep(1);
        if ((++sp & 255u) == 0u) { if (xb_ld(&bar[XB_TMO])) break; if (sp > XB_SPIN_CAP) { atomicAdd(&bar[XB_TMO], 1u); break; } }
    }
    nloc = mine > 0u ? mine : 1u; nx = cnt > 0u ? cnt : 1u;
}

__device__ __forceinline__ void xcd_barrier(const XcdBarrier& b) {
    asm volatile("s_waitcnt vmcnt(0)" ::: "memory");
    __syncthreads();
    if (threadIdx.x == 0) {
        unsigned* bar = b.bar;
        __builtin_amdgcn_s_waitcnt(0);
        unsigned nloc = b.st[0], nx = b.st[1];
        if (nloc == 0u) { xcd_barrier_complete(bar, b.x, nloc, nx); b.st[0] = nloc; b.st[1] = nx; }
        const unsigned old = xb_add(&bar[XB_XSUB(b.x)], 1u);
        const unsigned gen = old / nloc;
        if (old + 1u == (gen + 1u) * nloc) {
            __builtin_amdgcn_fence(__ATOMIC_RELEASE, "agent");
            asm volatile("s_waitcnt vmcnt(0)" ::: "memory");
            const unsigned og = xb_add(&bar[XB_TOP], 1u);
            const unsigned tg = og / nx;
            if (og + 1u == (tg + 1u) * nx) xb_add(&bar[XB_TOPGEN], 1u);
            else XB_SPIN(xb_ld(&bar[XB_TOPGEN]) == tg, bar);
            __builtin_amdgcn_fence(__ATOMIC_ACQUIRE, "agent");
            xb_add(&bar[XB_XGEN(b.x)], 1u);
            asm volatile("s_waitcnt vmcnt(0)" ::: "memory");
        } else {
            XB_SPIN(xb_ld(&bar[XB_XGEN(b.x)]) == gen, bar);
            __builtin_amdgcn_fence(__ATOMIC_ACQUIRE, "agent");
            asm volatile("s_waitcnt vmcnt(0)" ::: "memory");
        }
    }
    __syncthreads();
}

#ifndef FLAT_BARRIER
#define FLAT_BARRIER 0
#endif
__device__ __forceinline__ void flat_barrier(unsigned* cnt) {
    asm volatile("s_waitcnt vmcnt(0)" ::: "memory");
    __syncthreads();
    if (threadIdx.x == 0) {
        const unsigned G = gridDim.x;
        __builtin_amdgcn_fence(__ATOMIC_RELEASE, "agent");
        asm volatile("s_waitcnt vmcnt(0)" ::: "memory");
        const unsigned old = __hip_atomic_fetch_add(cnt, 1u, __ATOMIC_RELAXED, __HIP_MEMORY_SCOPE_AGENT);
        const unsigned target = (old / G + 1u) * G;
        unsigned sp = 0u;
        while (__hip_atomic_load(cnt, __ATOMIC_RELAXED, __HIP_MEMORY_SCOPE_AGENT) < target) { __builtin_amdgcn_s_sleep(1); if (++sp > (1u << 24)) break; }
        __builtin_amdgcn_fence(__ATOMIC_ACQUIRE, "agent");
        asm volatile("s_waitcnt vmcnt(0)" ::: "memory");
    }
    __syncthreads();
}

constexpr size_t al256(size_t x) { return (x + 255) & ~(size_t)255; }
constexpr size_t WS_BAR = 0, BAR_ZERO_BYTES = 16384;
constexpr size_t WS_SS = 16384;
constexpr size_t WS_WUP1 = 262144;
constexpr size_t SZ_WUP = (size_t)2 * DFF * DM * 2, SZ_WDN = (size_t)DM * DFF * 2, SZ_WIN = (size_t)DIN * DM * 2, SZ_WC = (size_t)DM * DCONV * 2, SZ_WO = (size_t)DM * DM * 2;
constexpr size_t WS_WDN1 = WS_WUP1 + SZ_WUP, WS_WIN = WS_WDN1 + SZ_WDN, WS_WC = WS_WIN + SZ_WIN, WS_WA = WS_WC + SZ_WC, WS_WO = WS_WA + SZ_WC, WS_WUP2 = WS_WO + SZ_WO, WS_WDN2 = WS_WUP2 + SZ_WUP;
constexpr size_t WS_XB = WS_WDN2 + SZ_WDN;
constexpr size_t SZ_XB = (size_t)MPAD * DM * 2;
constexpr size_t WS_YA_OLD = WS_XB;
constexpr size_t WS_Z = WS_XB + SZ_XB;
constexpr size_t SZ_Z = (size_t)MPAD * DIN * 2;
constexpr size_t WS_ACT = WS_Z;
constexpr size_t WS_X1 = WS_Z + SZ_Z;
constexpr size_t WS_END = WS_X1 + (size_t)MPAD * DM * 4;
constexpr size_t WS_YA = WS_X1, WS_AT = WS_X1 + SZ_XB / 2;
constexpr size_t WS_MIX = WS_WUP1;
static_assert(SZ_XB <= SZ_WUP && (size_t)MPAD * DFF * 2 <= SZ_Z, "aliases");

struct Args { const float* in[21]; float* out; unsigned char* ws; int ph_lo, ph_hi; };

__device__ __forceinline__ float wave_sum(float v) {
#pragma unroll
    for (int o = 1; o < 64; o <<= 1) v += __shfl_xor(v, o);
    return v;
}
__device__ __forceinline__ unsigned pk2(float lo, float hi) { return pg8::cvt_pk_bf16(lo, hi); }

__device__ __forceinline__ void p0_x_row(const float* xrow, bf16_t* orow, float* ssp, int lane, bool zero) {
    const f32x4_t* xr = (const f32x4_t*)xrow + lane;
    float s = 0.f; unsigned long long* o8 = (unsigned long long*)orow + lane;
#pragma unroll
    for (int j = 0; j < 8; ++j) {
        f32x4_t v = zero ? (f32x4_t){0.f, 0.f, 0.f, 0.f} : xr[64 * j];
        s += (v.x * v.x + v.y * v.y) + (v.z * v.z + v.w * v.w);
        o8[64 * j] = (unsigned long long)pk2(v.x, v.y) | ((unsigned long long)pk2(v.z, v.w) << 32);
    }
    s = wave_sum(s);
    if (lane == 0) *ssp = s;
}

constexpr int KS_PITCH = 72, VT_PITCH = 264, LDS_KS = 0, LDS_VT = 256 * KS_PITCH * 2;
constexpr float LOG2E = 1.4426950408889634f;

__device__ __forceinline__ void attn_head(const u32x4_t qa, const u32x4_t qc, int h, int iq, int qrow, int kb0, int smin, int smax, int r, int quad,
                                          const float* qg, const float* sinks, bf16_t* attn, LAS unsigned char* lds) {
    const float slope2 = __builtin_amdgcn_exp2f(-0.5f * (float)(h + 1)) * LOG2E, sink2 = sinks[h] * LOG2E;
    bf16x8_t qf[2];
    {
        float q0[8] = {bf_lo(qa.x), bf_hi(qa.x), bf_lo(qa.y), bf_hi(qa.y), bf_lo(qa.z), bf_hi(qa.z), bf_lo(qa.w), bf_hi(qa.w)};
        float q1[8] = {bf_lo(qc.x), bf_hi(qc.x), bf_lo(qc.y), bf_hi(qc.y), bf_lo(qc.z), bf_hi(qc.z), bf_lo(qc.w), bf_hi(qc.w)};
        float ssq = 0.f;
#pragma unroll
        for (int i = 0; i < 8; ++i) ssq += q0[i] * q0[i] + q1[i] * q1[i];
        ssq += __shfl_xor(ssq, 16); ssq += __shfl_xor(ssq, 32);
        const float rq = __builtin_amdgcn_rsqf(ssq * (1.0f / HD) + EPSN) * (0.125f * LOG2E);
        const f32x4_t g0a = *(const f32x4_t*)(qg + 8 * quad), g0b = *(const f32x4_t*)(qg + 8 * quad + 4), g1a = *(const f32x4_t*)(qg + 32 + 8 * quad), g1b = *(const f32x4_t*)(qg + 32 + 8 * quad + 4);
        u32x4_t p0, p1;
        p0.x = pk2(q0[0] * rq * g0a.x, q0[1] * rq * g0a.y); p0.y = pk2(q0[2] * rq * g0a.z, q0[3] * rq * g0a.w); p0.z = pk2(q0[4] * rq * g0b.x, q0[5] * rq * g0b.y); p0.w = pk2(q0[6] * rq * g0b.z, q0[7] * rq * g0b.w);
        p1.x = pk2(q1[0] * rq * g1a.x, q1[1] * rq * g1a.y); p1.y = pk2(q1[2] * rq * g1a.z, q1[3] * rq * g1a.w); p1.z = pk2(q1[4] * rq * g1b.x, q1[5] * rq * g1b.y); p1.w = pk2(q1[6] * rq * g1b.z, q1[7] * rq * g1b.w);
        qf[0] = __builtin_bit_cast(bf16x8_t, p0); qf[1] = __builtin_bit_cast(bf16x8_t, p1);
    }
    f32x4_t sc[10];
    const LAS unsigned char* kbase = lds + LDS_KS + (kb0 * 16 + r) * (KS_PITCH * 2) + quad * 16;
    float mx = -1e30f;
    const unsigned srange = (unsigned)(smax - smin);
#pragma unroll
    for (int kk = 0; kk < 9; ++kk) {
        const bf16x8_t k0 = *(const LAS bf16x8_t*)(kbase + kk * 16 * (KS_PITCH * 2)), k1 = *(const LAS bf16x8_t*)(kbase + kk * 16 * (KS_PITCH * 2) + 64);
        f32x4_t a = (f32x4_t){0.f, 0.f, 0.f, 0.f};
        a = __builtin_amdgcn_mfma_f32_16x16x32_bf16(k0, qf[0], a, 0, 0, 0);
        a = __builtin_amdgcn_mfma_f32_16x16x32_bf16(k1, qf[1], a, 0, 0, 0);
#pragma unroll
        for (int v = 0; v < 4; ++v) {
            const int s = 16 * (kb0 + kk) + 4 * quad + v, dist = 128 + iq - s;
            const bool ok = ((unsigned)dist <= 128u) && ((unsigned)(s - smin) < srange);
            const float x = ok ? a[v] - slope2 * (float)dist : -1e30f;
            a[v] = x; mx = fmaxf(mx, x);
        }
        sc[kk] = a;
        __builtin_amdgcn_sched_barrier(0);
    }
    mx = fmaxf(mx, __shfl_xor(mx, 16)); mx = fmaxf(mx, __shfl_xor(mx, 32)); mx = fmaxf(mx, sink2);
    float sum = 0.f;
#pragma unroll
    for (int kk = 0; kk < 9; ++kk)
#pragma unroll
        for (int v = 0; v < 4; ++v) { const float p = __builtin_amdgcn_exp2f(sc[kk][v] - mx); sc[kk][v] = p; sum += p; }
    sc[9] = (f32x4_t){0.f, 0.f, 0.f, 0.f};
    sum += __shfl_xor(sum, 16); sum += __shfl_xor(sum, 32);
    sum += __builtin_amdgcn_exp2f(sink2 - mx);
    const float inv = 1.0f / sum;
    f32x4_t o[4] = {(f32x4_t){0.f, 0.f, 0.f, 0.f}, (f32x4_t){0.f, 0.f, 0.f, 0.f}, (f32x4_t){0.f, 0.f, 0.f, 0.f}, (f32x4_t){0.f, 0.f, 0.f, 0.f}};
    const LAS unsigned char* vbase = lds + LDS_VT + (r * VT_PITCH + 16 * kb0 + 4 * quad) * 2;
#pragma unroll
    for (int ks = 0; ks < 5; ++ks) {
        u32x4_t pw; pw.x = pk2(sc[2 * ks][0], sc[2 * ks][1]); pw.y = pk2(sc[2 * ks][2], sc[2 * ks][3]); pw.z = pk2(sc[2 * ks + 1][0], sc[2 * ks + 1][1]); pw.w = pk2(sc[2 * ks + 1][2], sc[2 * ks + 1][3]);
        const bf16x8_t pf = __builtin_bit_cast(bf16x8_t, pw);
#pragma unroll
        for (int db = 0; db < 4; ++db) {
            const LAS unsigned char* vp = vbase + (db * 16 * VT_PITCH + 32 * ks) * 2;
            const u32x2_t lo2 = *(const LAS u32x2_t*)vp, hi2 = *(const LAS u32x2_t*)(vp + (ks < 4 ? 32 : 0));
            const u32x4_t vw = (u32x4_t){lo2.x, lo2.y, hi2.x, hi2.y};
            o[db] = __builtin_amdgcn_mfma_f32_16x16x32_bf16(__builtin_bit_cast(bf16x8_t, vw), pf, o[db], 0, 0, 0);
        }
        __builtin_amdgcn_sched_barrier(0);
    }
    bf16_t* op = attn + (size_t)qrow * QDIM + h * HD + 4 * quad;
#pragma unroll
    for (int db = 0; db < 4; ++db) { u32x2_t wv; wv.x = pk2(o[db][0] * inv, o[db][1] * inv); wv.y = pk2(o[db][2] * inv, o[db][3] * inv); *(u32x2_t*)(op + 16 * db) = wv; }
}

__device__ __forceinline__ void attn_unit(int kind, int b, int kh, int j, const bf16_t* z, const float* cache_k, const float* cache_v,
                                          const float* qg, const float* kg, const float* sinks, bf16_t* attn, float* out, LAS unsigned char* lds) {
    const int tid = threadIdx.x, lane = tid & 63, w = tid >> 6;
    int r = lane & 15, quad = lane >> 4;
    asm volatile("" : "+v"(r), "+v"(quad));
    bool active; int iq, gl, qrow, smin, smax;
    if (kind == 0) { active = !(j == 0 && w < 7); iq = 16 * w + r; gl = 0; qrow = b * LP + 128 * j + iq - 112; smin = (j == 0) ? 240 : (j == 1 ? 112 : 0); smax = 256; }
    else { active = (w == 0); iq = r >> 2; gl = r & 3; qrow = MP + b * DECT + iq; smin = 0; smax = NWIN + DECT; }
    u32x4_t qa[4], qc[4];
#pragma unroll
    for (int p = 0; p < 4; ++p) { qa[p] = (u32x4_t){0u, 0u, 0u, 0u}; qc[p] = (u32x4_t){0u, 0u, 0u, 0u}; }
    if (active) {
#pragma unroll
        for (int p = 0; p < 4; ++p) if (kind == 0 || p == 0) {
            const bf16_t* zq = z + (size_t)qrow * DIN + ZO_Q + (kh * 4 + (kind == 0 ? p : gl)) * HD + 8 * quad;
            qa[p] = *(const u32x4_t*)zq; qc[p] = *(const u32x4_t*)(zq + 32);
        }
    }
    {
        const int s = tid >> 1, hf = tid & 1;
        bool valid, need_norm = true; int row = 0;
        if (kind == 0) { const int tk = 128 * (j - 1) + s - 112; valid = tk >= 0; row = b * LP + tk; }
        else { valid = s < NWIN + DECT; need_norm = (s >= NWIN); row = MP + b * DECT + (s - NWIN); }
        const bool from_cache = (kind == 1 && s < NWIN);
        size_t oo = 0; bool wr_out = false;
        if (kind == 0) { if (j == 16 && s >= 128) { oo = ((size_t)(b * NWIN + (s - 128)) * NKV + kh) * HD + 32 * hf; wr_out = true; } }
        else { if (s >= DECT && s < NWIN + DECT) { oo = ((size_t)(b * NWIN + (s - DECT)) * NKV + kh) * HD + 32 * hf; wr_out = true; } }
        const size_t coff = ((size_t)(b * NWIN + s) * NKV + kh) * HD + 32 * hf;
        float kv[32], vv[32];
        if (!valid) {
#pragma unroll
            for (int i = 0; i < 32; ++i) { kv[i] = 0.f; vv[i] = 0.f; }
        } else if (from_cache) {
            const f32x4_t* ck = (const f32x4_t*)(cache_k + coff); const f32x4_t* cv = (const f32x4_t*)(cache_v + coff);
#pragma unroll
            for (int i = 0; i < 8; ++i) { const f32x4_t a = ck[i], c = cv[i]; kv[4 * i] = a.x; kv[4 * i + 1] = a.y; kv[4 * i + 2] = a.z; kv[4 * i + 3] = a.w; vv[4 * i] = c.x; vv[4 * i + 1] = c.y; vv[4 * i + 2] = c.z; vv[4 * i + 3] = c.w; }
        } else {
            const u32x4_t* zk = (const u32x4_t*)(z + (size_t)row * DIN + ZO_K + kh * HD + 32 * hf); const u32x4_t* zv = (const u32x4_t*)(z + (size_t)row * DIN + ZO_V + kh * HD + 32 * hf);
#pragma unroll
            for (int i = 0; i < 4; ++i) { const u32x4_t a = zk[i], c = zv[i];
                kv[8 * i] = bf_lo(a.x); kv[8 * i + 1] = bf_hi(a.x); kv[8 * i + 2] = bf_lo(a.y); kv[8 * i + 3] = bf_hi(a.y); kv[8 * i + 4] = bf_lo(a.z); kv[8 * i + 5] = bf_hi(a.z); kv[8 * i + 6] = bf_lo(a.w); kv[8 * i + 7] = bf_hi(a.w);
                vv[8 * i] = bf_lo(c.x); vv[8 * i + 1] = bf_hi(c.x); vv[8 * i + 2] = bf_lo(c.y); vv[8 * i + 3] = bf_hi(c.y); vv[8 * i + 4] = bf_lo(c.z); vv[8 * i + 5] = bf_hi(c.z); vv[8 * i + 6] = bf_lo(c.w); vv[8 * i + 7] = bf_hi(c.w); }
        }
        float ssq = 0.f;
#pragma unroll
        for (int i = 0; i < 32; ++i) ssq += kv[i] * kv[i];
        ssq += __shfl_xor(ssq, 1);
        if (valid && need_norm) {
            const float rinv = __builtin_amdgcn_rsqf(ssq * (1.0f / HD) + EPSN);
#pragma unroll
            for (int i = 0; i < 8; ++i) { const f32x4_t gg = *(const f32x4_t*)(kg + 32 * hf + 4 * i);
                kv[4 * i] *= rinv * gg.x; kv[4 * i + 1] *= rinv * gg.y; kv[4 * i + 2] *= rinv * gg.z; kv[4 * i + 3] *= rinv * gg.w; }
        }
        if (wr_out) { float* ko = out + ((kind == 0) ? OUT_KP : OUT_KS) + oo; float* vo = out + ((kind == 0) ? OUT_VP : OUT_VS) + oo;
#pragma unroll
            for (int i = 0; i < 8; ++i) { ((f32x4_t*)ko)[i] = (f32x4_t){kv[4 * i], kv[4 * i + 1], kv[4 * i + 2], kv[4 * i + 3]}; ((f32x4_t*)vo)[i] = (f32x4_t){vv[4 * i], vv[4 * i + 1], vv[4 * i + 2], vv[4 * i + 3]}; } }
        LAS u32x4_t* kd = (LAS u32x4_t*)(lds + LDS_KS + s * (KS_PITCH * 2) + hf * 64);
#pragma unroll
        for (int i = 0; i < 4; ++i) { u32x4_t o; o.x = pk2(kv[8 * i], kv[8 * i + 1]); o.y = pk2(kv[8 * i + 2], kv[8 * i + 3]); o.z = pk2(kv[8 * i + 4], kv[8 * i + 5]); o.w = pk2(kv[8 * i + 6], kv[8 * i + 7]); kd[i] = o; }
        LAS bf16_t* vt = (LAS bf16_t*)(lds + LDS_VT);
#pragma unroll
        for (int i = 0; i < 32; i += 2) { const unsigned p = pk2(vv[i], vv[i + 1]); vt[(32 * hf + i) * VT_PITCH + s] = (bf16_t)(p & 0xffffu); vt[(32 * hf + i + 1) * VT_PITCH + s] = (bf16_t)(p >> 16); }
    }
    __syncthreads();
    asm volatile("" : "+v"(iq));
    if (active) {
        const int kb0 = (kind == 0) ? w : 0;
#pragma unroll
        for (int p = 0; p < 4; ++p) if (kind == 0 || p == 0) {
            attn_head(qa[p], qc[p], kh * 4 + (kind == 0 ? p : gl), iq, qrow, kb0, smin, smax, r, quad, qg, sinks, attn, lds);
            __builtin_amdgcn_sched_barrier(0);
        }
    }
    __syncthreads();
}

__device__ __forceinline__ void load_u8(const bf16_t* z, int row, int c, float (&u)[8]) {
    const u32x4_t xc = *(const u32x4_t*)(z + (size_t)row * DIN + ZO_XC + c), cg_ = *(const u32x4_t*)(z + (size_t)row * DIN + ZO_CG + c);
    u[0] = bf_lo(xc.x) * bf_lo(cg_.x); u[1] = bf_hi(xc.x) * bf_hi(cg_.x); u[2] = bf_lo(xc.y) * bf_lo(cg_.y); u[3] = bf_hi(xc.y) * bf_hi(cg_.y);
    u[4] = bf_lo(xc.z) * bf_lo(cg_.z); u[5] = bf_hi(xc.z) * bf_hi(cg_.z); u[6] = bf_lo(xc.w) * bf_lo(cg_.w); u[7] = bf_hi(xc.w) * bf_hi(cg_.w);
}
__device__ __forceinline__ void load_f8(const float* p, float (&u)[8]) {
    const f32x4_t a = *(const f32x4_t*)p, b = *(const f32x4_t*)(p + 4);
    u[0] = a.x; u[1] = a.y; u[2] = a.z; u[3] = a.w; u[4] = b.x; u[5] = b.y; u[6] = b.z; u[7] = b.w;
}
__device__ __forceinline__ void conv_item(int ci, const bf16_t* z, const float* state, const float* cw, bf16_t* ya, float* out) {
    const int tid = threadIdx.x, c = (tid & 127) * 8, rsub = tid >> 7, rbase = 32 * ci + 8 * rsub;
    float w0[8], w1[8], w2[8];
    load_f8(cw + c, w0); load_f8(cw + DCONV + c, w1); load_f8(cw + 2 * DCONV + c, w2);
    u32x4_t xcw[10], cgw[10], bgw[8];
#pragma unroll
    for (int i = 0; i < 10; ++i) { const int row = rbase - 2 + i; const int rc = row < 0 ? 0 : row;
        xcw[i] = *(const u32x4_t*)(z + (size_t)rc * DIN + ZO_XC + c); cgw[i] = *(const u32x4_t*)(z + (size_t)rc * DIN + ZO_CG + c); }
#pragma unroll
    for (int i = 0; i < 8; ++i) bgw[i] = *(const u32x4_t*)(z + (size_t)(rbase + i) * DIN + ZO_BG + c);
    float u[10][8];
#pragma unroll
    for (int i = 0; i < 10; ++i) {
        const u32x4_t xc = xcw[i], cg_ = cgw[i];
        u[i][0] = bf_lo(xc.x) * bf_lo(cg_.x); u[i][1] = bf_hi(xc.x) * bf_hi(cg_.x); u[i][2] = bf_lo(xc.y) * bf_lo(cg_.y); u[i][3] = bf_hi(xc.y) * bf_hi(cg_.y);
        u[i][4] = bf_lo(xc.z) * bf_lo(cg_.z); u[i][5] = bf_hi(xc.z) * bf_hi(cg_.z); u[i][6] = bf_lo(xc.w) * bf_lo(cg_.w); u[i][7] = bf_hi(xc.w) * bf_hi(cg_.w);
    }
#pragma unroll
    for (int i = 0; i < 8; ++i) {
        const int row = rbase + i;
        int t, sq; const bool samp = row >= MP;
        if (!samp) { sq = row / LP; t = row - sq * LP; } else { sq = (row - MP) / DECT; t = (row - MP) - sq * DECT; }
        float u1[8], u2[8];
        if (t >= 1) {
#pragma unroll
            for (int e = 0; e < 8; ++e) u1[e] = u[i + 1][e];
        } else if (samp) load_f8(state + ((size_t)sq * 2 + 1) * DCONV + c, u1);
        else {
#pragma unroll
            for (int e = 0; e < 8; ++e) u1[e] = 0.f;
        }
        if (t >= 2) {
#pragma unroll
            for (int e = 0; e < 8; ++e) u2[e] = u[i][e];
        } else if (samp) load_f8(state + ((size_t)sq * 2 + t) * DCONV + c, u2);
        else {
#pragma unroll
            for (int e = 0; e < 8; ++e) u2[e] = 0.f;
        }
        const u32x4_t bw = bgw[i];
        const float bg[8] = {bf_lo(bw.x), bf_hi(bw.x), bf_lo(bw.y), bf_hi(bw.y), bf_lo(bw.z), bf_hi(bw.z), bf_lo(bw.w), bf_hi(bw.w)};
        float y[8];
#pragma unroll
        for (int e = 0; e < 8; ++e) y[e] = bg[e] * (w0[e] * u2[e] + w1[e] * u1[e] + w2[e] * u[i + 2][e]);
        u32x4_t o; o.x = pk2(y[0], y[1]); o.y = pk2(y[2], y[3]); o.z = pk2(y[4], y[5]); o.w = pk2(y[6], y[7]);
        *(u32x4_t*)(ya + (size_t)row * DCONV + c) = o;
        float* no = nullptr;
        if (!samp) { if (t >= LP - 2) no = out + OUT_CP + ((size_t)sq * 2 + (t - (LP - 2))) * DCONV + c; }
        else { if (t >= DECT - 2) no = out + OUT_CS + ((size_t)sq * 2 + (t - (DECT - 2))) * DCONV + c; }
        if (no) { *(f32x4_t*)no = (f32x4_t){u[i + 2][0], u[i + 2][1], u[i + 2][2], u[i + 2][3]}; *(f32x4_t*)(no + 4) = (f32x4_t){u[i + 2][4], u[i + 2][5], u[i + 2][6], u[i + 2][7]}; }
    }
}

template <int MODE> __device__ __forceinline__ void fix_resid(const float* part, int nsl, const float* xp, const float* xs, const float* meta, float* xbuf, bf16_t* xb, float* ss, float* out, int gw, int ngw, int lane) {
    for (int it = gw; it < NTAIL * 8; it += ngw) {
        const int rloc = it >> 3, row = TAIL0 + rloc, col = (it & 7) * 256 + lane * 4;
        const bf16_t* p = (const bf16_t*)part + (size_t)rloc * 2048 + col;
        f32x4_t v = (f32x4_t){0.f, 0.f, 0.f, 0.f};
#pragma unroll 8
        for (int s = 0; s < nsl; ++s) { const u32x2_t w = __builtin_nontemporal_load((const u32x2_t*)(p + (size_t)s * (256 * 2048))); v += (f32x4_t){bf_lo(w.x), bf_hi(w.x), bf_lo(w.y), bf_hi(w.y)}; }
        const float scale = (MODE == 1) ? 1.0f : 0.5f;
        const u32x2_t bw = *(const u32x2_t*)(xb + (size_t)row * DM + col);
        const f32x4_t o = (f32x4_t){bf_lo(bw.x), bf_hi(bw.x), bf_lo(bw.y), bf_hi(bw.y)} + v * scale;
        if (MODE == 2) { float* dst = y_row(out, row); if (dst) __builtin_nontemporal_store(o, (f32x4_t*)(dst + col)); }
        else {
            u32x2_t w; w.x = pk2(o.x, o.y); w.y = pk2(o.z, o.w); *(u32x2_t*)(xb + (size_t)row * DM + col) = w;
            const float sq = wave_sum((o.x * o.x + o.y * o.y) + (o.z * o.z + o.w * o.w));
            if (lane == 0) __hip_atomic_fetch_add(ss + row, sq, __ATOMIC_RELAXED, __HIP_MEMORY_SCOPE_AGENT);
        }
    }
}
__device__ __forceinline__ void fix_gate(const float* part, int nsl, const bf16_t* z, bf16_t* mixed, int gw, int ngw, int lane) {
    for (int it = gw; it < NTAIL * 8; it += ngw) {
        const int rloc = it >> 3, row = TAIL0 + rloc, col = (it & 7) * 256 + lane * 4;
        const bf16_t* p = (const bf16_t*)part + (size_t)rloc * 2048 + col;
        f32x4_t a = (f32x4_t){0.f, 0.f, 0.f, 0.f}, b = (f32x4_t){0.f, 0.f, 0.f, 0.f};
#pragma unroll 8
        for (int s = 0; s < nsl; ++s) { const u32x2_t wa = __builtin_nontemporal_load((const u32x2_t*)(p + (size_t)s * (256 * 2048))), wb = __builtin_nontemporal_load((const u32x2_t*)(p + (size_t)(s + nsl) * (256 * 2048)));
            a += (f32x4_t){bf_lo(wa.x), bf_hi(wa.x), bf_lo(wa.y), bf_hi(wa.y)}; b += (f32x4_t){bf_lo(wb.x), bf_hi(wb.x), bf_lo(wb.y), bf_hi(wb.y)}; }
        const u32x2_t gc = *(const u32x2_t*)(z + (size_t)row * DIN + ZO_GC + col), ga = *(const u32x2_t*)(z + (size_t)row * DIN + ZO_GA + col);
        u32x2_t w;
        w.x = pk2(bf_lo(gc.x) * a.x + bf_lo(ga.x) * b.x, bf_hi(gc.x) * a.y + bf_hi(ga.x) * b.y);
        w.y = pk2(bf_lo(gc.y) * a.z + bf_lo(ga.y) * b.z, bf_hi(gc.y) * a.w + bf_hi(ga.y) * b.w);
        *(u32x2_t*)(mixed + (size_t)row * DM + col) = w;
    }
}

constexpr int I_UP = (DM / 64) * (2 * DFF / 64), I_DN = (DFF / 64) * (DM / 64), I_IN = (DM / 64) * (DIN / 64), I_C = (DCONV / 64) * (DM / 64), I_O = (DM / 64) * (DM / 64);
constexpr int CI_DN1 = I_UP, CI_IN = CI_DN1 + I_DN, CI_C = CI_IN + I_IN, CI_A = CI_C + I_C, CI_O = CI_A + I_C, CI_UP2 = CI_O + I_O, CI_DN2 = CI_UP2 + I_UP, CI_END = CI_DN2 + I_DN;
struct CvtItem { const float* src; const float* gp; bf16_t* dst; int N, K; };
__device__ __forceinline__ void cvt_decode(int it, int lane, const Args& args, CvtItem& d) {
    const float* W; const float* gain = nullptr; int K, N, mode = 0, item, blk = 0; size_t wo;
    if (it < CI_DN1)      { W = args.in[7];  K = DM;    N = 2 * DFF; wo = WS_WUP1; gain = args.in[6];  mode = 1; item = it; blk = 1; }
    else if (it < CI_IN)  { W = args.in[8];  K = DFF;   N = DM;      wo = WS_WDN1; item = it - CI_DN1; blk = 1; }
    else if (it < CI_C)   { W = args.in[10]; K = DM;    N = DIN;     wo = WS_WIN;  gain = args.in[9];  item = it - CI_IN; blk = 1; }
    else if (it < CI_A)   { W = args.in[14]; K = DCONV; N = DM;      wo = WS_WC;   item = it - CI_C; }
    else if (it < CI_O)   { W = args.in[16]; K = QDIM;  N = DM;      wo = WS_WA;   item = it - CI_A; }
    else if (it < CI_UP2) { W = args.in[17]; K = DM;    N = DM;      wo = WS_WO;   item = it - CI_O; }
    else if (it < CI_DN2) { W = args.in[19]; K = DM;    N = 2 * DFF; wo = WS_WUP2; gain = args.in[18]; mode = 1; item = it - CI_UP2; blk = 1; }
    else                  { W = args.in[20]; K = DFF;   N = DM;      wo = WS_WDN2; item = it - CI_DN2; blk = 1; }
    const int nblk = N / 64, kb = item / nblk, nb = item - kb * nblk, k0 = 64 * kb, n0 = 64 * nb;
    int nd0 = n0;
    if (mode == 1) { if (n0 < DFF) nd0 = 256 * (n0 / 128) + (n0 % 128); else { const int j = n0 - DFF; nd0 = 256 * (j / 128) + 128 + (j % 128); } }
    d.src = W + (size_t)(k0 + (lane >> 4)) * N + n0 + (lane & 15) * 4;
    d.gp = gain ? gain + k0 + (lane >> 4) : nullptr;
    const int nrow = nd0 + (lane >> 3);
    if (blk) { d.dst = (bf16_t*)(args.ws + wo) + (((size_t)(nrow >> 8) * (K / 64) + kb) * 256 + (nrow & 255)) * 64 + 8 * (lane & 7); d.K = 64; }
    else { d.dst = (bf16_t*)(args.ws + wo) + (size_t)nrow * K + k0 + 8 * (lane & 7); d.K = K; }
    d.N = N;
}
__device__ __forceinline__ void cvt_load(const CvtItem& d, f32x4_t (&v)[16], float (&g)[16]) {
#pragma unroll
    for (int i = 0; i < 16; ++i) { v[i] = __builtin_nontemporal_load((const f32x4_t*)(d.src + (size_t)(4 * i) * d.N)); g[i] = d.gp ? d.gp[4 * i] : 1.0f; }
}
__device__ __forceinline__ void convert_range(int lo_it, int hi_it, int gw, int ngw, LAS unsigned char* lds, int wave, int lane_in, const Args& args) {
    int lane = lane_in; asm volatile("" : "+v"(lane));
    LAS float* scr = (LAS float*)(lds + wave * 16640);
    int it = lo_it + gw;
    if (it >= hi_it) return;
    CvtItem cur; f32x4_t v[16]; float g[16];
    cvt_decode(it, lane, args, cur); cvt_load(cur, v, g);
#pragma unroll 1
    for (;;) {
        const int itn = it + ngw; const bool more = itn < hi_it;
        CvtItem nxt = cur; f32x4_t vn[16]; float gn[16];
        if (more) { cvt_decode(itn, lane, args, nxt); cvt_load(nxt, vn, gn); }
        LAS float* d = scr + (lane >> 4) * 65 + (lane & 15) * 4;
#pragma unroll
        for (int i = 0; i < 16; ++i) { const f32x4_t x = v[i] * g[i]; LAS float* dd = d + (4 * i) * 65; dd[0] = x.x; dd[1] = x.y; dd[2] = x.z; dd[3] = x.w; }
        asm volatile("s_waitcnt lgkmcnt(0)" ::: "memory");
        const LAS float* s = scr + (8 * (lane & 7)) * 65 + (lane >> 3);
#pragma unroll
        for (int j = 0; j < 8; ++j) { const LAS float* sj = s + 8 * j;
            u32x4_t o; o.x = pk2(sj[0 * 65], sj[1 * 65]); o.y = pk2(sj[2 * 65], sj[3 * 65]); o.z = pk2(sj[4 * 65], sj[5 * 65]); o.w = pk2(sj[6 * 65], sj[7 * 65]);
            *(u32x4_t*)(cur.dst + (size_t)(8 * j) * cur.K) = o; }
        asm volatile("s_waitcnt lgkmcnt(0)" ::: "memory");
        if (!more) break;
        it = itn; cur = nxt;
#pragma unroll
        for (int i = 0; i < 16; ++i) { v[i] = vn[i]; g[i] = gn[i]; }
    }
}

__global__ void __launch_bounds__(NWAVES * 64, 2) fwd_megakernel(Args args) {
    extern __shared__ __attribute__((aligned(16))) unsigned char lds_raw[];
    LAS unsigned char* lds = (LAS unsigned char*)lds_raw;
    const int tid = threadIdx.x, lane = tid & 63, wave = __builtin_amdgcn_readfirstlane(tid >> 6);
    const int G = gridDim.x, bx = blockIdx.x;
    unsigned char* ws = args.ws;
    const float* x_prompt = args.in[0]; const float* x_sample = args.in[1]; const float* state_conv = args.in[2]; const float* cache_k = args.in[3]; const float* cache_v = args.in[4];
    const float* meta = args.in[5]; const float* g_ffn1 = args.in[6]; const float* w_up1 = args.in[7]; const float* w_dn1 = args.in[8]; const float* g_mix = args.in[9];
    const float* w_in = args.in[10]; const float* q_g = args.in[11]; const float* k_g = args.in[12]; const float* conv_w = args.in[13]; const float* w_conv_out = args.in[14];
    const float* sinks = args.in[15]; const float* w_attn_out = args.in[16]; const float* w_o = args.in[17]; const float* g_ffn2 = args.in[18]; const float* w_up2 = args.in[19]; const float* w_dn2 = args.in[20];
    float* out = args.out;
    float* ss0 = (float*)(ws + WS_SS); float* ss1 = ss0 + MPAD; float* ss2 = ss1 + MPAD;
    bf16_t* Wup1 = (bf16_t*)(ws + WS_WUP1); bf16_t* Wdn1 = (bf16_t*)(ws + WS_WDN1); bf16_t* Win = (bf16_t*)(ws + WS_WIN); bf16_t* Wc = (bf16_t*)(ws + WS_WC); bf16_t* Wa = (bf16_t*)(ws + WS_WA);
    bf16_t* Wo = (bf16_t*)(ws + WS_WO); bf16_t* Wup2 = (bf16_t*)(ws + WS_WUP2); bf16_t* Wdn2 = (bf16_t*)(ws + WS_WDN2);
    bf16_t* xb = (bf16_t*)(ws + WS_XB); bf16_t* ya = (bf16_t*)(ws + WS_YA); bf16_t* at = (bf16_t*)(ws + WS_AT); bf16_t* zb = (bf16_t*)(ws + WS_Z); bf16_t* act = (bf16_t*)(ws + WS_ACT);
    float* x1 = (float*)(ws + WS_X1); bf16_t* mixed = (bf16_t*)(ws + WS_MIX);
    const int lo = args.ph_lo, hi = args.ph_hi;
    const int GG_UP = (G >= 64) ? G - 16 : G / 2, GG_IN = (G >= 64) ? G - 24 : G / 2;
    if (hi > 1000) cg::this_grid().sync();
    if (tid < 2) ((volatile LAS unsigned*)(lds + LDS_MISC_OFF))[tid] = 0u;
    __syncthreads();
    XcdBarrier bar = xcd_barrier_post((unsigned*)(ws + WS_BAR), (volatile LAS unsigned*)(lds + LDS_MISC_OFF));
#ifndef PH_MASK
#define PH_MASK 0x1fff
#endif
#define IN(k) (((PH_MASK >> (k)) & 1) && lo <= (k) && (k) < hi)
#define SEAM(k) do { if (IN(k) && IN((k) + 1)) { if (FLAT_BARRIER) flat_barrier((unsigned*)(ws + WS_BAR) + 64); else xcd_barrier(bar); } } while (0)

    for (int rep_ = 0; rep_ < ((PROBE_DUP == 1) ? 2 : 1); ++rep_)
    if (IN(0)) {
        const int gw = bx * NWAVES + wave, NGW = G * NWAVES;
        convert_range(0, CI_DN1, gw, NGW, lds, wave, lane, args);
        for (int m = gw; m < MPAD; m += 2 * NGW) {
            const int m2 = m + NGW; const bool has2 = m2 < MPAD, za = m >= MV, zb_ = (!has2) || m2 >= MV;
            const f32x4_t* xa = (const f32x4_t*)x0_row(x_prompt, x_sample, meta, m) + lane;
            const f32x4_t* xc = (const f32x4_t*)x0_row(x_prompt, x_sample, meta, has2 ? m2 : m) + lane;
            f32x4_t va[8], vb[8];
#pragma unroll
            for (int j = 0; j < 8; ++j) { va[j] = za ? (f32x4_t){0.f, 0.f, 0.f, 0.f} : __builtin_nontemporal_load(xa + 64 * j); vb[j] = zb_ ? (f32x4_t){0.f, 0.f, 0.f, 0.f} : __builtin_nontemporal_load(xc + 64 * j); }
            float sa = 0.f, sb = 0.f;
            unsigned long long* oa = (unsigned long long*)(xb + (size_t)m * DM) + lane; unsigned long long* ob = (unsigned long long*)(xb + (size_t)(has2 ? m2 : m) * DM) + lane;
#pragma unroll
            for (int j = 0; j < 8; ++j) {
                sa += (va[j].x * va[j].x + va[j].y * va[j].y) + (va[j].z * va[j].z + va[j].w * va[j].w);
                sb += (vb[j].x * vb[j].x + vb[j].y * vb[j].y) + (vb[j].z * vb[j].z + vb[j].w * vb[j].w);
                oa[64 * j] = (unsigned long long)pk2(va[j].x, va[j].y) | ((unsigned long long)pk2(va[j].z, va[j].w) << 32);
                if (has2) ob[64 * j] = (unsigned long long)pk2(vb[j].x, vb[j].y) | ((unsigned long long)pk2(vb[j].z, vb[j].w) << 32);
            }
            sa = wave_sum(sa); sb = wave_sum(sb);
            if (lane == 0) { ss0[m] = sa; ss1[m] = 0.f; ss2[m] = 0.f; if (has2) { ss0[m2] = sb; ss1[m2] = 0.f; ss2[m2] = 0.f; } }
        }
    }
    SEAM(0);
    if (PROBE_DUP == 3) { for (int rep_ = 0; rep_ < 16; ++rep_) SEAM(0); }
    const int gw = bx * NWAVES + wave, NGW = G * NWAVES;
    float* part_o = out;
    float* part_w = (float*)(ws + WS_WDN1);
    for (int rep_ = 0; rep_ < ((PROBE_DUP == 4) ? 2 : 1); ++rep_)
    if (IN(1)) {
        if (bx < GG_UP) { pg8::Gemm g{xb, Wup1, MPAD, 2 * DFF, DM, nullptr, 0, 1}; pg8::StaticOrder S; S.init(MPAD, 2 * DFF, DM, GG_UP, bx);
            pg8::EpiSwiglu E{act, ss0};
            pg8::gemm_phase<pg8::EpiSwiglu, pg8::StaticOrder, true, true>(lds, g, S, E); }
        else convert_range(CI_DN1, CI_C, (bx - GG_UP) * NWAVES + wave, (G - GG_UP) * NWAVES, lds, wave, lane, args);
    }
    SEAM(1);
    if (IN(2)) {
        pg8::Gemm g{act, Wdn1, MPAD, DM, DFF, part_o, 1, 1}; pg8::TailOrder S; S.init(DFF, 32, 0, G, bx);
        pg8::EpiResid<0> E{x_prompt, x_sample, meta, x1, xb, ss1, out};
        pg8::gemm_phase<pg8::EpiResid<0>, pg8::TailOrder, true, true>(lds, g, S, E);
    }
    SEAM(2);
    if (IN(3)) fix_resid<0>(part_o, 32, x_prompt, x_sample, meta, x1, xb, ss1, out, gw, NGW, lane);
    SEAM(3);
    for (int rep_ = 0; rep_ < ((PROBE_DUP == 5) ? 2 : 1); ++rep_)
    if (IN(4)) {
        if (bx < GG_IN) { pg8::Gemm g{xb, Win, MPAD, DIN, DM, nullptr, 0, 1}; pg8::StaticOrder S; S.init(MPAD, DIN, DM, GG_IN, bx);
            pg8::EpiZ E{zb, ss1};
            pg8::gemm_phase<pg8::EpiZ, pg8::StaticOrder, true, true>(lds, g, S, E); }
        else convert_range(CI_C, CI_DN2, (bx - GG_IN) * NWAVES + wave, (G - GG_IN) * NWAVES, lds, wave, lane, args);
    }
    SEAM(4);
    for (int rep_ = 0; rep_ < ((PROBE_DUP == 2) ? 2 : 1); ++rep_)
    if (IN(5)) {
        constexpr int N_PH = NB * NKV * 16, N_PL = NB * NKV, N_SA = DECB * NKV, N_CV = MV / 32, N_IT = N_PH + N_PL + N_SA + N_CV;
        for (int it = bx; it < N_IT; it += G) {
            if (it < N_PH + N_PL) { const int bk = (it < N_PH) ? (it >> 4) : (it - N_PH), j = (it < N_PH) ? 1 + (it & 15) : 0; attn_unit(0, bk >> 2, bk & 3, j, zb, cache_k, cache_v, q_g, k_g, sinks, at, out, lds); }
            else if (it < N_PH + N_PL + N_SA) { const int u = it - N_PH - N_PL; attn_unit(1, u >> 2, u & 3, 0, zb, cache_k, cache_v, q_g, k_g, sinks, at, out, lds); }
            else conv_item(it - N_PH - N_PL - N_SA, zb, state_conv, conv_w, ya, out);
        }
    }
    SEAM(5);
    if (IN(6)) {
#pragma unroll 1
        for (int pass = 0; pass < 2; ++pass) {
            pg8::Gemm g{pass ? at : ya, pass ? Wa : Wc, MPAD, DM, DCONV, (float*)((bf16_t*)part_o + (size_t)pass * 8 * 256 * 2048), 0, 0}; pg8::TailOrder S; S.init(DCONV, 8, pass * 64, G, bx);
            pg8::EpiGate E{mixed, zb, pass};
            pg8::gemm_phase<pg8::EpiGate, pg8::TailOrder, true, true>(lds, g, S, E);
        }
    }
    SEAM(6);
    if (IN(7)) fix_gate(part_o, 8, zb, mixed, gw, NGW, lane);
    SEAM(7);
    if (IN(8)) {
        pg8::Gemm g{mixed, Wo, MPAD, DM, DM, part_o, 0, 0}; pg8::TailOrder S; S.init(DM, 16, 0, G, bx);
        pg8::EpiResid<1> E{x_prompt, x_sample, meta, x1, xb, ss2, out};
        pg8::gemm_phase<pg8::EpiResid<1>, pg8::TailOrder, true, true>(lds, g, S, E);
    }
    SEAM(8);
    if (IN(9)) fix_resid<1>(part_o, 16, x_prompt, x_sample, meta, x1, xb, ss2, out, gw, NGW, lane);
    SEAM(9);
    if (IN(10)) {
        if (bx < GG_UP) { pg8::Gemm g{xb, Wup2, MPAD, 2 * DFF, DM, nullptr, 0, 1}; pg8::StaticOrder S; S.init(MPAD, 2 * DFF, DM, GG_UP, bx);
            pg8::EpiSwiglu E{act, ss2};
            pg8::gemm_phase<pg8::EpiSwiglu, pg8::StaticOrder, true, true>(lds, g, S, E); }
        else convert_range(CI_DN2, CI_END, (bx - GG_UP) * NWAVES + wave, (G - GG_UP) * NWAVES, lds, wave, lane, args);
    }
    SEAM(10);
    for (int rep_ = 0; rep_ < ((PROBE_DUP == 6) ? 2 : 1); ++rep_) {
    if (rep_ == 1) { if (FLAT_BARRIER) flat_barrier((unsigned*)(ws + WS_BAR) + 64); else xcd_barrier(bar); }
    if (IN(11)) {
        pg8::Gemm g{act, Wdn2, MPAD, DM, DFF, part_w, 1, 1}; pg8::TailOrder S; S.init(DFF, 32, 0, G, bx);
        pg8::EpiResid<2> E{x_prompt, x_sample, meta, x1, xb, ss2, out};
        pg8::gemm_phase<pg8::EpiResid<2>, pg8::TailOrder, true, true>(lds, g, S, E);
    }
    SEAM(11);
    if (IN(12)) fix_resid<2>(part_w, 32, x_prompt, x_sample, meta, x1, xb, ss2, out, gw, NGW, lane);
    }
#undef IN
#undef SEAM
}

extern "C" void kernel_launch(void* const* d_in, const int* in_sizes, int n_in, void* d_out, int out_size, void* d_ws, size_t ws_size, hipStream_t stream) {
    static int grid = 0;
    if (grid == 0) {
        if (n_in != 21 || out_size != (int)OUT_END || ws_size < WS_END) { fprintf(stderr, "kernel_launch: unexpected shapes: n_in %d out %d ws %zu (need %zu)\n", n_in, out_size, ws_size, (size_t)WS_END); grid = -1; return; }
        int dev = 0, cus = 0, per_cu = 0;
        if (hipGetDevice(&dev) != hipSuccess || hipDeviceGetAttribute(&cus, hipDeviceAttributeMultiprocessorCount, dev) != hipSuccess) { grid = -1; return; }
        if (hipFuncSetAttribute((const void*)fwd_megakernel, hipFuncAttributeMaxDynamicSharedMemorySize, LDS_BYTES) != hipSuccess) { fprintf(stderr, "kernel_launch: hipFuncSetAttribute failed\n"); grid = -1; return; }
        if (hipOccupancyMaxActiveBlocksPerMultiprocessor(&per_cu, (const void*)fwd_megakernel, NWAVES * 64, LDS_BYTES) != hipSuccess || per_cu < 1) { fprintf(stderr, "kernel_launch: occupancy query says %d\n", per_cu); per_cu = 1; }
        (void)hipGetLastError();
        grid = cus;
    }
    if (grid < 0) return;
    if (hipMemsetAsync((char*)d_ws + WS_BAR, 0, BAR_ZERO_BYTES, stream) != hipSuccess) { fprintf(stderr, "kernel_launch: memset failed\n"); return; }
    Args a{};
    for (int i = 0; i < 21; ++i) a.in[i] = (const float*)d_in[i];
    a.out = (float*)d_out; a.ws = (unsigned char*)d_ws;
    if (MK_N_LAUNCHES == 1) {
        a.ph_lo = 0; a.ph_hi = N_PHASES;
        void* kargs[] = {&a};
        const hipError_t e = hipLaunchCooperativeKernel((const void*)fwd_megakernel, dim3(grid), dim3(NWAVES * 64), kargs, LDS_BYTES, stream);
        if (e != hipSuccess) fprintf(stderr, "kernel_launch: cooperative launch failed: %s (grid %d)\n", hipGetErrorString(e), grid);
    } else {
        for (int p = 0; p < N_PHASES; ++p) { a.ph_lo = p; a.ph_hi = p + 1; hipLaunchKernelGGL(fwd_megakernel, dim3(grid), dim3(NWAVES * 64), LDS_BYTES, stream, a); }
    }
}
```
